# Optimizing an MI355X kernel written in HIP

```python
import jax, jax.numpy as jnp
from jax import lax
import numpy as np

D_MODEL = 1024
BATCH = 8
SEQ = 8192
DEPTH = 1
DEC_BATCH = 8
DEC_SEQ = 64
PAST_LEN = 4096

CHUNK = 64
N_HEADS = 8
N_KV_HEADS = 2
GROUP = N_HEADS // N_KV_HEADS
HEAD_DIM = 64
ATTN_WIDTH = N_HEADS * HEAD_DIM
KV_WIDTH = N_KV_HEADS * HEAD_DIM
WINDOW = 128
WINDOW_CHUNKS = WINDOW // CHUNK
ROT_DIM = HEAD_DIM // 4
ROPE_THETA = 500000.0
LRU_WIDTH = D_MODEL - ATTN_WIDTH
LRU_BLOCKS = 8
LRU_BLOCK = LRU_WIDTH // LRU_BLOCKS
CONV_WIDTH = 4
LRU_C = 8.0
MIX_WIDTH = ATTN_WIDTH + LRU_WIDTH
IN_COLS = ATTN_WIDTH + 2 * KV_WIDTH + 2 * LRU_WIDTH
D_FF = 2816
PLE_DIM = 256
ALPHA = (2.0 * DEPTH) ** 0.25
BETA = (8.0 * DEPTH) ** -0.25
LN_EPS = 1e-5
NEG_INF = -1e30

kernel_name = 'hybrid_streaming_swa_rglru_step'


def _layer_norm(x, g, b):
    xf = x.astype(jnp.float32)
    mu = jnp.mean(xf, -1, keepdims=True)
    var = jnp.mean(jnp.square(xf - mu), -1, keepdims=True)
    y = (xf - mu) * lax.rsqrt(var + LN_EPS)
    return (y * g.astype(jnp.float32) + b.astype(jnp.float32)).astype(x.dtype)


def _swiglu(x, wg, wu, wd):
    return (jax.nn.silu(x @ wg) * (x @ wu)) @ wd


def _rope(x, pos):
    half = ROT_DIM // 2
    inv = jnp.power(jnp.float32(ROPE_THETA), -jnp.arange(half, dtype=jnp.float32) * (2.0 / ROT_DIM))
    ang = pos.astype(jnp.float32)[:, None] * inv[None, :]
    cos = jnp.cos(ang)[None, :, None, :].astype(x.dtype)
    sin = jnp.sin(ang)[None, :, None, :].astype(x.dtype)
    x1 = x[..., :half]
    x2 = x[..., half:ROT_DIM]
    return jnp.concatenate([x1 * cos - x2 * sin, x2 * cos + x1 * sin, x[..., ROT_DIM:]], axis=-1)


def _sink_attention(q, kb, vb, sinks, valid):
    s = jnp.einsum('bncvgd,bnkvd->bnvgck', q, kb).astype(jnp.float32) * (HEAD_DIM ** -0.5)
    if valid is not None:
        s = jnp.where(valid[None, :, None, None, None, :], s, NEG_INF)
    sink = sinks.astype(jnp.float32).reshape(N_KV_HEADS, GROUP)[None, None, :, :, None, None]
    m = jnp.maximum(jnp.max(s, axis=-1, keepdims=True), sink)
    pr = jnp.exp(s - m)
    denom = jnp.sum(pr, axis=-1, keepdims=True) + jnp.exp(sink - m)
    w = (pr / denom).astype(vb.dtype)
    return jnp.einsum('bnvgck,bnkvd->bncvgd', w, vb)


def _prompt_attention(q, k, v, sinks):
    B, S = q.shape[0], q.shape[1]
    nc = S // CHUNK
    qc = q.reshape(B, nc, CHUNK, N_KV_HEADS, GROUP, HEAD_DIM)

    def band(t):
        tc = t.reshape(B, nc, CHUNK, N_KV_HEADS, HEAD_DIM)
        tp = jnp.pad(tc, ((0, 0), (WINDOW_CHUNKS, 0), (0, 0), (0, 0), (0, 0)))
        return jnp.concatenate([tp[:, j:j + nc] for j in range(WINDOW_CHUNKS + 1)], axis=2)

    key_chunk = jnp.arange(nc)[:, None] - WINDOW_CHUNKS + (jnp.arange((WINDOW_CHUNKS + 1) * CHUNK) // CHUNK)[None, :]
    o = _sink_attention(qc, band(k), band(v), sinks, key_chunk >= 0)
    return o.reshape(B, S, ATTN_WIDTH), k[:, -WINDOW:], v[:, -WINDOW:]


def _sample_attention(q, k, v, k_past, v_past, sinks):
    B, T = q.shape[0], q.shape[1]
    k_all = jnp.concatenate([k_past.astype(k.dtype), k], axis=1)
    v_all = jnp.concatenate([v_past.astype(v.dtype), v], axis=1)
    qc = q.reshape(B, 1, T, N_KV_HEADS, GROUP, HEAD_DIM)
    o = _sink_attention(qc, k_all[:, None], v_all[:, None], sinks, None)
    return o.reshape(B, T, ATTN_WIDTH), k_all[:, -WINDOW:], v_all[:, -WINDOW:]


def _lin_combine(c1, c2):
    a1, b1 = c1
    a2, b2 = c2
    return a1 * a2, a2 * b1 + b2


def _rglru(xb, conv_prev, h_prev, conv_w, conv_b, w_a, b_a, w_x, b_x, lam):
    B, T = xb.shape[0], xb.shape[1]
    xp = jnp.concatenate([conv_prev.astype(xb.dtype), xb], axis=1)
    new_conv = xp[:, -(CONV_WIDTH - 1):]
    xc = conv_b + conv_w[0] * xp[:, 0:T]
    for j in range(1, CONV_WIDTH):
        xc = xc + conv_w[j] * xp[:, j:j + T]
    xf = xc.astype(jnp.float32)
    xr = xf.reshape(B, T, LRU_BLOCKS, LRU_BLOCK)
    r = jax.nn.sigmoid(jnp.einsum('btnc,ncd->btnd', xr, w_a.astype(jnp.float32)).reshape(B, T, LRU_WIDTH) + b_a.astype(jnp.float32))
    i = jax.nn.sigmoid(jnp.einsum('btnc,ncd->btnd', xr, w_x.astype(jnp.float32)).reshape(B, T, LRU_WIDTH) + b_x.astype(jnp.float32))
    log_a = -LRU_C * jax.nn.softplus(-lam.astype(jnp.float32)) * r
    a = jnp.exp(log_a)
    u = jnp.sqrt(-jnp.expm1(2.0 * log_a)) * (i * xf)
    u = u.at[:, 0].add(a[:, 0] * h_prev.astype(jnp.float32))
    _, hs = lax.associative_scan(_lin_combine, (a, u), axis=1)
    return hs, new_conv, hs[:, -1]


def _layer(x, p, pos, k_past, v_past, conv_prev, h_prev, prm):
    B, T = x.shape[0], x.shape[1]
    h = _layer_norm(ALPHA * x + 0.5 * _swiglu(x, prm['ffn1_wg'], prm['ffn1_wu'], prm['ffn1_wd']), prm['ln1_g'], prm['ln1_b'])
    z = h @ prm['w_in']
    o1 = ATTN_WIDTH
    o2 = o1 + KV_WIDTH
    o3 = o2 + KV_WIDTH
    o4 = o3 + LRU_WIDTH
    q = _rope(z[..., :o1].reshape(B, T, N_HEADS, HEAD_DIM), pos)
    k = _rope(z[..., o1:o2].reshape(B, T, N_KV_HEADS, HEAD_DIM), pos)
    v = z[..., o2:o3].reshape(B, T, N_KV_HEADS, HEAD_DIM)
    xb = z[..., o3:o4]
    gb = z[..., o4:]
    if k_past is None:
        attn, new_k, new_v = _prompt_attention(q, k, v, prm['attn_sinks'])
    else:
        attn, new_k, new_v = _sample_attention(q, k, v, k_past, v_past, prm['attn_sinks'])
    hs, new_conv, new_h = _rglru(xb, conv_prev, h_prev, prm['conv_w'], prm['conv_b'], prm['lru_wa'], prm['lru_ba'], prm['lru_wx'], prm['lru_bx'], prm['lru_lambda'])
    lru = (hs * jax.nn.gelu(gb.astype(jnp.float32))).astype(x.dtype)
    mix = jnp.concatenate([attn, lru], axis=-1) @ prm['w_out']
    h = _layer_norm(ALPHA * h + mix, prm['ln2_g'], prm['ln2_b'])
    h = _layer_norm(ALPHA * h + 0.5 * _swiglu(h, prm['ffn2_wg'], prm['ffn2_wu'], prm['ffn2_wd']), prm['ln3_g'], prm['ln3_b'])
    y = h + jax.nn.sigmoid(h @ prm['w_ple_gate']) * (p @ prm['w_ple'])
    return y, new_k, new_v, new_conv, new_h


def setup_inputs(seed: int = 0) -> dict:
    key = jax.random.key(seed)
    ks = jax.random.split(key, 40)
    f32 = jnp.float32
    L = DEPTH
    D = D_MODEL

    def nrm(k, shape, scale):
        return jax.random.normal(k, shape, f32) * scale

    u = jax.random.uniform(ks[30], (L, LRU_WIDTH), f32, 0.9, 0.999)
    s = u ** (1.0 / LRU_C)
    lam = jnp.log(s) - jnp.log1p(-s)
    return {
        'x_prompt': nrm(ks[0], (BATCH, SEQ, D), 1.0),
        'x_sample': nrm(ks[1], (DEC_BATCH, DEC_SEQ, D), 1.0),
        'p_prompt': nrm(ks[2], (L, BATCH, SEQ, PLE_DIM), 1.0),
        'p_sample': nrm(ks[3], (L, DEC_BATCH, DEC_SEQ, PLE_DIM), 1.0),
        'cache_k': nrm(ks[4], (L, DEC_BATCH, WINDOW, N_KV_HEADS, HEAD_DIM), 1.0),
        'cache_v': nrm(ks[5], (L, DEC_BATCH, WINDOW, N_KV_HEADS, HEAD_DIM), 1.0),
        'state_conv': nrm(ks[6], (L, DEC_BATCH, CONV_WIDTH - 1, LRU_WIDTH), 1.0),
        'state_h': nrm(ks[7], (L, DEC_BATCH, LRU_WIDTH), 0.5),
        'ffn1_wg': nrm(ks[8], (L, D, D_FF), D ** -0.5),
        'ffn1_wu': nrm(ks[9], (L, D, D_FF), D ** -0.5),
        'ffn1_wd': nrm(ks[10], (L, D_FF, D), BETA * D_FF ** -0.5),
        'ln1_g': 1.0 + nrm(ks[11], (L, D), 0.02),
        'ln1_b': nrm(ks[12], (L, D), 0.02),
        'w_in': nrm(ks[13], (L, D, IN_COLS), D ** -0.5),
        'attn_sinks': nrm(ks[14], (L, N_HEADS), 0.5),
        'conv_w': nrm(ks[15], (L, CONV_WIDTH, LRU_WIDTH), CONV_WIDTH ** -0.5),
        'conv_b': nrm(ks[16], (L, LRU_WIDTH), 0.02),
        'lru_wa': nrm(ks[17], (L, LRU_BLOCKS, LRU_BLOCK, LRU_BLOCK), LRU_BLOCK ** -0.5),
        'lru_ba': nrm(ks[18], (L, LRU_WIDTH), 0.02),
        'lru_wx': nrm(ks[19], (L, LRU_BLOCKS, LRU_BLOCK, LRU_BLOCK), LRU_BLOCK ** -0.5),
        'lru_bx': nrm(ks[20], (L, LRU_WIDTH), 0.02),
        'lru_lambda': lam,
        'w_out': nrm(ks[21], (L, MIX_WIDTH, D), BETA * MIX_WIDTH ** -0.5),
        'ln2_g': 1.0 + nrm(ks[22], (L, D), 0.02),
        'ln2_b': nrm(ks[23], (L, D), 0.02),
        'ffn2_wg': nrm(ks[24], (L, D, D_FF), D ** -0.5),
        'ffn2_wu': nrm(ks[25], (L, D, D_FF), D ** -0.5),
        'ffn2_wd': nrm(ks[26], (L, D_FF, D), BETA * D_FF ** -0.5),
        'ln3_g': 1.0 + nrm(ks[27], (L, D), 0.02),
        'ln3_b': nrm(ks[28], (L, D), 0.02),
        'w_ple': nrm(ks[29], (L, PLE_DIM, D), PLE_DIM ** -0.5),
        'w_ple_gate': nrm(ks[31], (L, D, D), D ** -0.5),
    }


def reference(x_prompt, x_sample, p_prompt, p_sample, cache_k, cache_v, state_conv, state_h,
              ffn1_wg, ffn1_wu, ffn1_wd, ln1_g, ln1_b, w_in, attn_sinks, conv_w, conv_b,
              lru_wa, lru_ba, lru_wx, lru_bx, lru_lambda, w_out, ln2_g, ln2_b,
              ffn2_wg, ffn2_wu, ffn2_wd, ln3_g, ln3_b, w_ple, w_ple_gate):
    pos_prompt = jnp.arange(x_prompt.shape[1])
    pos_sample = PAST_LEN + jnp.arange(x_sample.shape[1])
    yp, ys = x_prompt, x_sample
    kp_l, vp_l, cp_l, hp_l = [], [], [], []
    ks_l, vs_l, cs_l, hs_l = [], [], [], []
    for i in range(DEPTH):
        prm = dict(ffn1_wg=ffn1_wg[i], ffn1_wu=ffn1_wu[i], ffn1_wd=ffn1_wd[i], ln1_g=ln1_g[i], ln1_b=ln1_b[i],
                   w_in=w_in[i], attn_sinks=attn_sinks[i], conv_w=conv_w[i], conv_b=conv_b[i],
                   lru_wa=lru_wa[i], lru_ba=lru_ba[i], lru_wx=lru_wx[i], lru_bx=lru_bx[i], lru_lambda=lru_lambda[i],
                   w_out=w_out[i], ln2_g=ln2_g[i], ln2_b=ln2_b[i], ffn2_wg=ffn2_wg[i], ffn2_wu=ffn2_wu[i],
                   ffn2_wd=ffn2_wd[i], ln3_g=ln3_g[i], ln3_b=ln3_b[i], w_ple=w_ple[i], w_ple_gate=w_ple_gate[i])
        bp = yp.shape[0]
        conv0 = jnp.zeros((bp, CONV_WIDTH - 1, LRU_WIDTH), yp.dtype)
        h0 = jnp.zeros((bp, LRU_WIDTH), jnp.float32)
        yp, kp, vp, cp, hp = _layer(yp, p_prompt[i], pos_prompt, None, None, conv0, h0, prm)
        ys, kn, vn, cn, hn = _layer(ys, p_sample[i], pos_sample, cache_k[i], cache_v[i], state_conv[i], state_h[i], prm)
        kp_l.append(kp); vp_l.append(vp); cp_l.append(cp); hp_l.append(hp)
        ks_l.append(kn); vs_l.append(vn); cs_l.append(cn); hs_l.append(hn)
    return (yp, ys, jnp.stack(kp_l), jnp.stack(vp_l), jnp.stack(cp_l), jnp.stack(hp_l),
            jnp.stack(ks_l), jnp.stack(vs_l), jnp.stack(cs_l), jnp.stack(hs_l))
```

```cpp
#include <hip/hip_runtime.h>
#include <hip/hip_cooperative_groups.h>
#include <cstdio>
#include <cstdint>
namespace cg = cooperative_groups;

#define LAS __attribute__((address_space(3)))
typedef unsigned short bf16_t;
typedef short bf16x8 __attribute__((ext_vector_type(8)));
typedef float f32x4 __attribute__((ext_vector_type(4)));
typedef float f32x2 __attribute__((ext_vector_type(2)));
typedef unsigned u32x4 __attribute__((ext_vector_type(4)));
typedef unsigned u32x2 __attribute__((ext_vector_type(2)));

constexpr int MP = 65536, MS = 512, MT = MP + MS;
constexpr int DM = 1024, FF = 2816, NIN = 1792, PLE = 256;
constexpr float ALPHA = 1.189207115002721f;
constexpr float LN_EPS = 1e-5f;
constexpr size_t O_Y = 0, O_NKP = 67633152, O_NVP = 67764224, O_NCP = 67895296, O_NHP = 67907584,
                 O_NKS = 67911680, O_NVS = 68042752, O_NCS = 68173824, O_NHS = 68186112;
constexpr size_t MiB = 1u << 20;
constexpr size_t WS_W1GU = 0, WS_W1D = 12 * MiB, WS_WIN = 18 * MiB, WS_WOUT = 22 * MiB, WS_W2GU = 24 * MiB, WS_W2D = 36 * MiB,
                 WS_WPG = 42 * MiB, WS_WPLE = 44 * MiB, WS_LRUW = 45 * MiB, WS_ROPE = 46 * MiB, WS_CP = 47 * MiB, WS_CH = 49 * MiB,
                 WS_XB = 64 * MiB  , WS_ACT = 194 * MiB  , WS_H1 = 550 * MiB  ,
                 WS_Z = 680 * MiB  , WS_PB = 906 * MiB, WS_END = 940 * MiB;

namespace pg8 {
constexpr int BM = 256, BK = 64, HALF = 128, HTB = HALF * BK * 2, STAGE_BYTES = 8 * HTB, NXCD = 8, WGM = 8;
__host__ __device__ __forceinline__ int lds_byte(int r, int c) { const int st = (r >> 4) * 2 + (c >> 5), rr = r & 15, cc = c & 31, ob = rr * 64 + cc * 2; return st * 1024 + (ob ^ (((ob >> 9) & 1) << 5)); }
__host__ __device__ __forceinline__ void stage_rc(int b, int& R, int& C) { const int st = b / 1024, sb = b % 1024, swz = sb ^ (((sb >> 9) & 1) << 5); R = (st >> 1) * 16 + swz / 64; C = (st & 1) * 32 + (swz % 64) / 2; }
__host__ __device__ __forceinline__ int perm32(int rho) { const int n = rho >> 4, i = rho & 15; return 8 * (i >> 2) + 4 * n + (i & 3); }
struct Unit { int pm, pn; };
struct Gemm { const bf16_t* A; const bf16_t* Bt; int M, N, K; };
struct StaticOrder {
    int nM, nN, nwg, G, c;
    __host__ __device__ void init(int M, int N, int G_, int c_) { nM = M / BM; nN = N / BM; nwg = nM * nN; G = G_; c = c_; }
    __host__ __device__ bool next(int i, Unit& u) const {
        const long L = (long)i * G + c; if (L >= nwg) return false;
        int wgid = (int)L; { const int q = nwg / NXCD, r = nwg % NXCD, xcd = wgid % NXCD, off = wgid / NXCD; wgid = (xcd < r ? xcd * (q + 1) : r * (q + 1) + (xcd - r) * q) + off; }
        const int nig = WGM * nN, gid = wgid / nig, fm = gid * WGM, gsz = (nM - fm) < WGM ? (nM - fm) : WGM;
        u.pm = fm + ((wgid % nig) % gsz); u.pn = (wgid % nig) / gsz; return true;
    }
    __device__ __forceinline__ void a_ready(const Unit&) const {}
    __device__ __forceinline__ void done(const Unit&) const {}
};
__device__ __forceinline__ unsigned cvt_pk_bf16(float lo, float hi) { unsigned r; asm volatile("v_cvt_pk_bf16_f32 %0, %1, %2" : "=v"(r) : "v"(lo), "v"(hi)); return r; }

template <class Epi, class Sched, bool ALIGN_EPI = false, bool SP2 = false>
__device__ __forceinline__ void gemm_phase(LAS unsigned char* lds, const Gemm g, const Sched& S, const Epi& E) {
    int tid_op = threadIdx.x; asm volatile("" : "+v"(tid_op));
    const int tid = tid_op, wid = __builtin_amdgcn_readfirstlane(tid >> 6), lane = tid & 63, wr = wid >> 2, wc = wid & 3, fr = lane & 15, fq = lane >> 4;
    int Kop = g.K; asm volatile("" : "+s"(Kop));
    const int K = Kop, nt = K / BK;
    unsigned voffA[2], voffB[2];
#pragma unroll
    for (int i = 0; i < 2; ++i) { int R, C; stage_rc(tid * 16 + i * 8192, R, C); const int Rb = Epi::PERM ? ((R & ~31) + perm32(R & 31)) : R;
        voffA[i] = (unsigned)(R * K + C) * 2u; voffB[i] = (unsigned)(Rb * K + C) * 2u; }
    const size_t kstep = (size_t)(BK * 2);
    const size_t hstep = (size_t)HALF * K * 2;
    const size_t tstep = 2 * hstep;
    const unsigned ldsw = (unsigned)wid * 1024u;
    const int aoff = lds_byte(wr * 64 + fr, fq * 8), boff = lds_byte(wc * 32 + fr, fq * 8);
#define PG8_SA(b, h) (((b) * 2 + (h)) * HTB)
#define PG8_SB(b, h) ((4 + (b) * 2 + (h)) * HTB)
#define PG8_STAGE(bufoff, gbase, voff) do { _Pragma("unroll") for (int _i = 0; _i < 2; ++_i) \
        __builtin_amdgcn_global_load_lds((const unsigned*)((const char*)(gbase) + (voff)[_i]), (LAS unsigned*)(lds + (bufoff) + ldsw + _i * 8192), 16, 0, 0); } while (0)
#define PG8_LDA(dst, b, h) do { _Pragma("unroll") for (int m = 0; m < 4; ++m) _Pragma("unroll") for (int k = 0; k < 2; ++k) dst[m][k] = *(const LAS bf16x8*)(lds + PG8_SA(b, h) + aoff + m * 2048 + k * 1024); } while (0)
#define PG8_LDB(dst, b, h) do { _Pragma("unroll") for (int n = 0; n < 2; ++n) _Pragma("unroll") for (int k = 0; k < 2; ++k) dst[n][k] = *(const LAS bf16x8*)(lds + PG8_SB(b, h) + boff + n * 2048 + k * 1024); } while (0)
#define PG8_MMA(ai, bj, At, Bt) do { __builtin_amdgcn_s_setprio(1); _Pragma("unroll") for (int m = 0; m < 4; ++m) _Pragma("unroll") for (int n = 0; n < 2; ++n) _Pragma("unroll") for (int k = 0; k < 2; ++k) \
        acc[ai][bj][m][n] = __builtin_amdgcn_mfma_f32_16x16x32_bf16(Bt[n][k], At[m][k], acc[ai][bj][m][n], 0, 0, 0); __builtin_amdgcn_s_setprio(0); } while (0)
#define PG8_WAIT_V(n) asm volatile("s_waitcnt vmcnt(" #n ")" ::: "memory")
#define PG8_WAIT_L(n) asm volatile("s_waitcnt lgkmcnt(" #n ")" ::: "memory")
#define PG8_BAR __builtin_amdgcn_s_barrier()
#define PG8_SCHED __builtin_amdgcn_sched_barrier(0)
    Unit cur, nxt; int ui = 0;
    if (!S.next(0, cur)) return;
    f32x4 acc[2][2][4][2];
#pragma unroll
    for (int a = 0; a < 2; ++a)
#pragma unroll
        for (int b = 0; b < 2; ++b)
#pragma unroll
            for (int m = 0; m < 4; ++m)
#pragma unroll
                for (int n = 0; n < 2; ++n) acc[a][b][m][n] = (f32x4){0.f, 0.f, 0.f, 0.f};
    bf16x8 At[4][2], B0[2][2], B1[2][2];
    const char* cA = (const char*)g.A + (size_t)cur.pm * tstep; const char* cB = (const char*)g.Bt + (size_t)cur.pn * tstep;
    S.a_ready(cur);
    if constexpr (SP2) {
        PG8_STAGE(PG8_SB(0, 0), cB, voffB); PG8_STAGE(PG8_SB(0, 1), cB + hstep, voffB); PG8_STAGE(PG8_SA(0, 0), cA, voffA); PG8_STAGE(PG8_SA(0, 1), cA + hstep, voffA);
        if (wr == 1) PG8_BAR;
        PG8_WAIT_V(2); PG8_BAR;
        PG8_STAGE(PG8_SB(1, 0), cB + kstep, voffB); PG8_STAGE(PG8_SA(1, 0), cA + kstep, voffA); PG8_STAGE(PG8_SB(1, 1), cB + hstep + kstep, voffB);
        PG8_WAIT_V(6); PG8_BAR;
    } else {
        PG8_STAGE(PG8_SB(0, 0), cB, voffB); PG8_STAGE(PG8_SA(0, 0), cA, voffA); PG8_STAGE(PG8_SB(0, 1), cB + hstep, voffB); PG8_STAGE(PG8_SA(0, 1), cA + hstep, voffA);
        if (wr == 1) PG8_BAR;
        PG8_WAIT_V(4); PG8_BAR;
        PG8_STAGE(PG8_SB(1, 0), cB + kstep, voffB); PG8_STAGE(PG8_SA(1, 0), cA + kstep, voffA); PG8_STAGE(PG8_SB(1, 1), cB + hstep + kstep, voffB);
        PG8_WAIT_V(6); PG8_BAR;
    }
    for (;;) {
        const bool has_next = S.next(ui + 1, nxt);
        const char* nA = has_next ? (const char*)g.A + (size_t)nxt.pm * tstep : cA; const char* nB = has_next ? (const char*)g.Bt + (size_t)nxt.pn * tstep : cB;
        for (int t = 0; t < nt; t += 2) {
            const bool last = (t == nt - 2);
            const char* a1 = cA + (size_t)(t + 1) * kstep;
            const char* a2 = last ? nA : cA + (size_t)(t + 2) * kstep; const char* b2 = last ? nB : cB + (size_t)(t + 2) * kstep;
            const char* a3 = a2 + kstep; const char* b3 = b2 + kstep;
            if (last && has_next) S.a_ready(nxt);
            if constexpr (SP2) {
            PG8_LDB(B0, 0, 0); PG8_LDB(B1, 0, 1); PG8_SCHED; PG8_LDA(At, 0, 0); PG8_STAGE(PG8_SA(1, 1), a1 + hstep, voffA);
            PG8_WAIT_V(8); PG8_WAIT_L(0); PG8_BAR; PG8_MMA(0, 0, At, B0); PG8_MMA(0, 1, At, B1); PG8_BAR; PG8_SCHED;
            PG8_LDA(At, 0, 1); PG8_STAGE(PG8_SB(0, 0), b2, voffB); PG8_STAGE(PG8_SB(0, 1), b2 + hstep, voffB); PG8_STAGE(PG8_SA(0, 0), a2, voffA);
            PG8_WAIT_V(8); PG8_WAIT_L(0); PG8_BAR; PG8_MMA(1, 0, At, B0); PG8_MMA(1, 1, At, B1); PG8_BAR; PG8_SCHED;
            PG8_LDB(B0, 1, 0); PG8_LDB(B1, 1, 1); PG8_SCHED; PG8_LDA(At, 1, 0); PG8_STAGE(PG8_SA(0, 1), a2 + hstep, voffA);
            PG8_WAIT_V(8); PG8_WAIT_L(0); PG8_BAR; PG8_MMA(0, 0, At, B0); PG8_MMA(0, 1, At, B1); PG8_BAR; PG8_SCHED;
            PG8_LDA(At, 1, 1); PG8_STAGE(PG8_SB(1, 0), b3, voffB); PG8_STAGE(PG8_SB(1, 1), b3 + hstep, voffB); PG8_STAGE(PG8_SA(1, 0), a3, voffA);
            PG8_WAIT_V(8); PG8_WAIT_L(0); PG8_BAR; PG8_MMA(1, 0, At, B0); PG8_MMA(1, 1, At, B1); PG8_BAR; PG8_SCHED;
            } else {
            PG8_LDB(B0, 0, 0); PG8_SCHED; PG8_LDA(At, 0, 0); PG8_STAGE(PG8_SA(1, 1), a1 + hstep, voffA);
            PG8_WAIT_L(8); PG8_BAR; PG8_WAIT_L(0); PG8_MMA(0, 0, At, B0); PG8_BAR; PG8_SCHED;
            PG8_LDB(B1, 0, 1); PG8_STAGE(PG8_SB(0, 0), b2, voffB);
            PG8_BAR; PG8_WAIT_L(0); PG8_MMA(0, 1, At, B1); PG8_BAR;
            PG8_LDA(At, 0, 1); PG8_STAGE(PG8_SA(0, 0), a2, voffA);
            PG8_BAR; PG8_WAIT_L(0); PG8_MMA(1, 0, At, B0); PG8_BAR; PG8_SCHED;
            PG8_STAGE(PG8_SB(0, 1), b2 + hstep, voffB);
            PG8_WAIT_V(6); PG8_BAR; PG8_MMA(1, 1, At, B1); PG8_BAR;
            PG8_LDB(B0, 1, 0); PG8_SCHED; PG8_LDA(At, 1, 0); PG8_STAGE(PG8_SA(0, 1), a2 + hstep, voffA);
            PG8_WAIT_L(8); PG8_BAR; PG8_WAIT_L(0); PG8_MMA(0, 0, At, B0); PG8_BAR; PG8_SCHED;
            PG8_LDB(B1, 1, 1); PG8_STAGE(PG8_SB(1, 0), b3, voffB);
            PG8_BAR; PG8_WAIT_L(0); PG8_MMA(0, 1, At, B1); PG8_BAR;
            PG8_LDA(At, 1, 1); PG8_STAGE(PG8_SA(1, 0), a3, voffA);
            PG8_BAR; PG8_WAIT_L(0); PG8_MMA(1, 0, At, B0); PG8_BAR; PG8_SCHED;
            PG8_STAGE(PG8_SB(1, 1), b3 + hstep, voffB);
            PG8_WAIT_V(6); PG8_BAR; PG8_MMA(1, 1, At, B1); PG8_BAR;
            }
        }
        if constexpr (ALIGN_EPI) { if (wr == 0) PG8_BAR; }
        E(acc, cur, wr, wc, fr, fq);
        if (!has_next) break;
#pragma unroll
        for (int a = 0; a < 2; ++a)
#pragma unroll
            for (int b = 0; b < 2; ++b)
#pragma unroll
                for (int m = 0; m < 4; ++m)
#pragma unroll
                    for (int n = 0; n < 2; ++n) acc[a][b][m][n] = (f32x4){0.f, 0.f, 0.f, 0.f};
        cur = nxt; cA = nA; cB = nB; ++ui;
        if constexpr (ALIGN_EPI) { if (wr == 1) PG8_BAR; }
    }
    PG8_WAIT_V(0);
    if constexpr (!ALIGN_EPI) { if (wr == 0) PG8_BAR; }
    PG8_BAR;
#undef PG8_SA
#undef PG8_SB
#undef PG8_STAGE
#undef PG8_LDA
#undef PG8_LDB
#undef PG8_MMA
#undef PG8_WAIT_V
#undef PG8_WAIT_L
#undef PG8_BAR
#undef PG8_SCHED
}
}
using pg8::cvt_pk_bf16;
using pg8::Unit;

__device__ __forceinline__ float fast_sigmoid(float x) { return __builtin_amdgcn_rcpf(1.0f + __expf(-x)); }

struct EpiSwiglu {
    static constexpr bool PERM = true;
    bf16_t* O;
    __device__ __forceinline__ void operator()(const f32x4 (&acc)[2][2][4][2], const Unit& u, int wr, int wc, int fr, int fq) const {
        const int row0 = u.pm * 256 + wr * 64 + fr, col0 = u.pn * 128 + wc * 32 + 8 * fq;
#pragma unroll
        for (int ai = 0; ai < 2; ++ai)
#pragma unroll
            for (int m = 0; m < 4; ++m) {
                const f32x4 g0 = acc[ai][0][m][0], g1 = acc[ai][0][m][1], u0 = acc[ai][1][m][0], u1 = acc[ai][1][m][1];
                float v[8];
#pragma unroll
                for (int j = 0; j < 4; ++j) { v[j] = g0[j] * fast_sigmoid(g0[j]) * u0[j]; v[4 + j] = g1[j] * fast_sigmoid(g1[j]) * u1[j]; }
                u32x4 w; w.x = cvt_pk_bf16(v[0], v[1]); w.y = cvt_pk_bf16(v[2], v[3]); w.z = cvt_pk_bf16(v[4], v[5]); w.w = cvt_pk_bf16(v[6], v[7]);
                *(u32x4*)(O + (size_t)(row0 + ai * 128 + m * 16) * FF + col0) = w;
            }
    }
};
struct EpiResid {
    static constexpr bool PERM = false;
    const float* resP; const float* resS; float* T; float sacc;
    __device__ __forceinline__ void operator()(const f32x4 (&acc)[2][2][4][2], const Unit& u, int wr, int wc, int fr, int fq) const {
        const float* res = (u.pm >= 256) ? (resS - (size_t)MP * DM) : resP;
        const int row0 = u.pm * 256 + wr * 64 + fr, col0 = u.pn * 256 + wc * 32 + 4 * fq;
#pragma unroll
        for (int ai = 0; ai < 2; ++ai)
#pragma unroll
            for (int m = 0; m < 4; ++m) {
                const size_t off = (size_t)(row0 + ai * 128 + m * 16) * DM + col0;
#pragma unroll
                for (int bj = 0; bj < 2; ++bj)
#pragma unroll
                    for (int n = 0; n < 2; ++n) {
                        const f32x4 r = *(const f32x4*)(res + off + bj * 128 + n * 16);
                        *(f32x4*)(T + off + bj * 128 + n * 16) = r * ALPHA + acc[ai][bj][m][n] * sacc;
                    }
            }
    }
};
struct EpiBf16 {
    static constexpr bool PERM = true;
    bf16_t* O; int ldc;
    __device__ __forceinline__ void operator()(const f32x4 (&acc)[2][2][4][2], const Unit& u, int wr, int wc, int fr, int fq) const {
        const int row0 = u.pm * 256 + wr * 64 + fr, col0 = u.pn * 256 + wc * 32 + 8 * fq;
#pragma unroll
        for (int ai = 0; ai < 2; ++ai)
#pragma unroll
            for (int m = 0; m < 4; ++m)
#pragma unroll
                for (int bj = 0; bj < 2; ++bj) {
                    const f32x4 v0 = acc[ai][bj][m][0], v1 = acc[ai][bj][m][1];
                    u32x4 w; w.x = cvt_pk_bf16(v0[0], v0[1]); w.y = cvt_pk_bf16(v0[2], v0[3]); w.z = cvt_pk_bf16(v1[0], v1[1]); w.w = cvt_pk_bf16(v1[2], v1[3]);
                    *(u32x4*)(O + (size_t)(row0 + ai * 128 + m * 16) * ldc + col0 + bj * 128) = w;
                }
    }
};
struct EpiWin {
    static constexpr bool PERM = true;
    bf16_t* Z; const float* rope; float* out;
    __device__ __forceinline__ void operator()(const f32x4 (&acc)[2][2][4][2], const Unit& u, int wr, int wc, int fr, int fq) const {
        const int tile = u.pn;
        const int row0 = u.pm * 256 + wr * 64 + fr;
#pragma unroll
        for (int ai = 0; ai < 2; ++ai)
#pragma unroll
            for (int m = 0; m < 4; ++m) {
                const int row = row0 + ai * 128 + m * 16;
                const bool samp = row >= MP;
                int b, t, pos;
                if (samp) { const int rs = row - MP; b = rs >> 6; t = rs & 63; pos = 4096 + t; } else { b = row >> 13; t = row & 8191; pos = t; }
#pragma unroll
                for (int bj = 0; bj < 2; ++bj) {
                    f32x4 v0 = acc[ai][bj][m][0], v1 = acc[ai][bj][m][1];
                    const int cin = bj * 128 + wc * 32 + 8 * fq;
                    if (tile < 2 || (tile == 2 && bj == 0)) {
                        f32x4 p0, p1;
#pragma unroll
                        for (int j = 0; j < 4; ++j) { p0[j] = __shfl_xor(v0[j], 16); p1[j] = __shfl_xor(v1[j], 16); }
                        if ((wc & 1) == 0 && fq < 2) {
                            const f32x4* rp = (const f32x4*)(rope + (size_t)pos * 16);
                            const f32x4 c0 = rp[0], c1 = rp[1], s0 = rp[2], s1 = rp[3];
                            const float sg = (fq == 0) ? -1.f : 1.f;
                            v0 = v0 * c0 + p0 * s0 * sg; v1 = v1 * c1 + p1 * s1 * sg;
                        }
                    }
                    u32x4 w; w.x = cvt_pk_bf16(v0[0], v0[1]); w.y = cvt_pk_bf16(v0[2], v0[3]); w.z = cvt_pk_bf16(v1[0], v1[1]); w.w = cvt_pk_bf16(v1[2], v1[3]);
                    *(u32x4*)(Z + (size_t)row * NIN + tile * 256 + cin) = w;
                }
                asm volatile("" ::: "memory");
            }
    }
};
struct EpiFinal {
    static constexpr bool PERM = false;
    float* Y; const bf16_t* PE;
    __device__ __forceinline__ void operator()(const f32x4 (&acc)[2][2][4][2], const Unit& u, int wr, int wc, int fr, int fq) const {
        const int row0 = u.pm * 256 + wr * 64 + fr, col0 = u.pn * 256 + wc * 32 + 4 * fq;
#pragma unroll
        for (int ai = 0; ai < 2; ++ai)
#pragma unroll
            for (int m = 0; m < 4; ++m) {
                const size_t off = (size_t)(row0 + ai * 128 + m * 16) * DM + col0;
#pragma unroll
                for (int bj = 0; bj < 2; ++bj)
#pragma unroll
                    for (int n = 0; n < 2; ++n) {
                        const size_t o = off + bj * 128 + n * 16;
                        const f32x4 h = *(const f32x4*)(Y + o);
                        const u32x2 pw = *(const u32x2*)(PE + o);
                        const f32x4 a = acc[ai][bj][m][n];
                        f32x4 pe; pe[0] = __uint_as_float(pw.x << 16); pe[1] = __uint_as_float(pw.x & 0xffff0000u); pe[2] = __uint_as_float(pw.y << 16); pe[3] = __uint_as_float(pw.y & 0xffff0000u);
                        f32x4 y;
#pragma unroll
                        for (int j = 0; j < 4; ++j) y[j] = h[j] + fast_sigmoid(a[j]) * pe[j];
                        *(f32x4*)(Y + o) = y;
                    }
            }
    }
};

struct Args { const float* in[32]; float* out; unsigned char* ws; };

__device__ __forceinline__ float wave_sum(float v) {
#pragma unroll
    for (int o = 1; o < 64; o <<= 1) v += __shfl_xor(v, o);
    return v;
}
__device__ __forceinline__ float bf2f(unsigned short h) { return __uint_as_float(((unsigned)h) << 16); }

__device__ __forceinline__ void transpose_item(const float* W, int K, int N, bf16_t* WT, int k0, int n0, int drow0, LAS float* scr, int lane) {
#pragma unroll 8
    for (int i = 0; i < 32; ++i) { const int kk = 2 * i + (lane >> 5); scr[kk * 33 + (lane & 31)] = W[(size_t)(k0 + kk) * N + n0 + (lane & 31)]; }
    asm volatile("s_waitcnt lgkmcnt(0)" ::: "memory");
    const int c = lane & 7;
#pragma unroll
    for (int j = 0; j < 4; ++j) { const int n = (lane >> 3) + 8 * j; const LAS float* s = scr + (8 * c) * 33 + n;
        u32x4 o; o.x = cvt_pk_bf16(s[0 * 33], s[1 * 33]); o.y = cvt_pk_bf16(s[2 * 33], s[3 * 33]); o.z = cvt_pk_bf16(s[4 * 33], s[5 * 33]); o.w = cvt_pk_bf16(s[6 * 33], s[7 * 33]);
        *(u32x4*)(WT + (size_t)(drow0 + n) * K + k0 + 8 * c) = o; }
    asm volatile("s_waitcnt lgkmcnt(0)" ::: "memory");
}
__device__ __forceinline__ void transpose_matrix_item(const float* W, int K, int N, bf16_t* WT, int mode, int item, LAS float* scr, int lane) {
    const int nblk = N / 32, kb = item / nblk, nb = item % nblk, n0 = 32 * nb;
    const int drow0 = (mode == 0) ? n0 : ((n0 >> 7) * 256 + (n0 & 127) + (mode == 2 ? 128 : 0));
    transpose_item(W, K, N, WT, 64 * kb, n0, drow0, scr, lane);
}

__device__ __forceinline__ void ln_row(float* trow, const float* g, const float* b, bf16_t* hrow, int lane) {
    f32x4* xr = (f32x4*)trow + lane;
    f32x4 v[4]; float s = 0.f;
#pragma unroll
    for (int j = 0; j < 4; ++j) { v[j] = xr[64 * j]; s += (v[j][0] + v[j][1]) + (v[j][2] + v[j][3]); }
    const float mean = wave_sum(s) * (1.f / DM); float s2 = 0.f;
#pragma unroll
    for (int j = 0; j < 4; ++j) { v[j] = v[j] - mean; s2 += (v[j][0] * v[j][0] + v[j][1] * v[j][1]) + (v[j][2] * v[j][2] + v[j][3] * v[j][3]); }
    const float rstd = 1.f / sqrtf(wave_sum(s2) * (1.f / DM) + LN_EPS);
    u32x2* o8 = (u32x2*)hrow + lane;
#pragma unroll
    for (int j = 0; j < 4; ++j) {
        const f32x4 gg = ((const f32x4*)g)[lane + 64 * j], bb = ((const f32x4*)b)[lane + 64 * j];
        const f32x4 y = v[j] * rstd * gg + bb;
        xr[64 * j] = y;
        u32x2 w; w.x = cvt_pk_bf16(y[0], y[1]); w.y = cvt_pk_bf16(y[2], y[3]); o8[64 * j] = w;
    }
}

constexpr int KP = 72  , VP = 196  ;
constexpr int ATT_K_OFF = 0, ATT_V_OFF = 192 * KP * 2;
__device__ __forceinline__ void attn_unit(LAS unsigned char* lds, const bf16_t* Z, bf16_t* MIX, const float* cache_k, const float* cache_v, const float* sinks, int item) {
    const int tid = threadIdx.x, lane = tid & 63, wave = __builtin_amdgcn_readfirstlane(tid >> 6), l16 = lane & 15, fq = lane >> 4;
    const bool samp = item >= 2048;
    int b, c, kvh;
    if (samp) { const int s = item - 2048; kvh = s & 1; b = s >> 1; c = 2; } else { kvh = item & 1; c = (item >> 1) & 127; b = item >> 8; }
    const int qtok0 = samp ? (MP + b * 64) : (b * 8192 + c * 64);
    const int k_lo = (!samp && c < 2) ? (2 - c) * 64 : 0;
    LAS bf16_t* KL = (LAS bf16_t*)(lds + ATT_K_OFF);
    LAS bf16_t* VL = (LAS bf16_t*)(lds + ATT_V_OFF);
    __syncthreads();
#pragma unroll
    for (int i = 0; i < 3; ++i) {
        const int p = tid + 512 * i, row = p >> 3, seg = p & 7;
        u32x4 kv = {0u, 0u, 0u, 0u}, vv = {0u, 0u, 0u, 0u};
        if (samp && row < 128) {
            const float* ks = cache_k + ((size_t)(b * 128 + row) * 128 + kvh * 64 + seg * 8);
            const float* vs = cache_v + ((size_t)(b * 128 + row) * 128 + kvh * 64 + seg * 8);
            const f32x4 k0 = *(const f32x4*)ks, k1 = *(const f32x4*)(ks + 4), v0 = *(const f32x4*)vs, v1 = *(const f32x4*)(vs + 4);
            kv.x = cvt_pk_bf16(k0[0], k0[1]); kv.y = cvt_pk_bf16(k0[2], k0[3]); kv.z = cvt_pk_bf16(k1[0], k1[1]); kv.w = cvt_pk_bf16(k1[2], k1[3]);
            vv.x = cvt_pk_bf16(v0[0], v0[1]); vv.y = cvt_pk_bf16(v0[2], v0[3]); vv.z = cvt_pk_bf16(v1[0], v1[1]); vv.w = cvt_pk_bf16(v1[2], v1[3]);
        } else if (row >= k_lo) {
            const int tok = samp ? (MP + b * 64 + (row - 128)) : (b * 8192 + (c - 2) * 64 + row);
            const bf16_t* zr = Z + (size_t)tok * NIN + kvh * 64 + seg * 8;
            kv = *(const u32x4*)(zr + 512); vv = *(const u32x4*)(zr + 640);
        }
        *(LAS u32x4*)(KL + row * KP + seg * 8) = kv;
        LAS bf16_t* vd = VL + (seg * 8) * VP + row;
        vd[0 * VP] = (bf16_t)(vv.x & 0xffff); vd[1 * VP] = (bf16_t)(vv.x >> 16); vd[2 * VP] = (bf16_t)(vv.y & 0xffff); vd[3 * VP] = (bf16_t)(vv.y >> 16);
        vd[4 * VP] = (bf16_t)(vv.z & 0xffff); vd[5 * VP] = (bf16_t)(vv.z >> 16); vd[6 * VP] = (bf16_t)(vv.w & 0xffff); vd[7 * VP] = (bf16_t)(vv.w >> 16);
    }
    __syncthreads();
    const int g = wave >> 1, qh = wave & 1, h = kvh * 4 + g;
    const float sink = sinks[h];
    bf16x8 Qf[2][2];
#pragma unroll
    for (int qt = 0; qt < 2; ++qt)
#pragma unroll
        for (int ks = 0; ks < 2; ++ks) Qf[qt][ks] = *(const bf16x8*)(Z + (size_t)(qtok0 + 32 * qh + 16 * qt + l16) * NIN + h * 64 + 32 * ks + 8 * fq);
    f32x4 S[12][2];
#pragma unroll
    for (int kt = 0; kt < 12; ++kt) {
        S[kt][0] = (f32x4){0.f, 0.f, 0.f, 0.f}; S[kt][1] = (f32x4){0.f, 0.f, 0.f, 0.f};
#pragma unroll
        for (int ks = 0; ks < 2; ++ks) {
            const bf16x8 Kf = *(const LAS bf16x8*)(KL + (16 * kt + l16) * KP + 32 * ks + 8 * fq);
            S[kt][0] = __builtin_amdgcn_mfma_f32_16x16x32_bf16(Kf, Qf[0][ks], S[kt][0], 0, 0, 0);
            S[kt][1] = __builtin_amdgcn_mfma_f32_16x16x32_bf16(Kf, Qf[1][ks], S[kt][1], 0, 0, 0);
        }
    }
    float inv[2];
#pragma unroll
    for (int qt = 0; qt < 2; ++qt) {
        float mx = sink;
#pragma unroll
        for (int kt = 0; kt < 12; ++kt) {
            const bool ok = (16 * kt >= k_lo);
#pragma unroll
            for (int r = 0; r < 4; ++r) { const float s = ok ? S[kt][qt][r] * 0.125f : -1e30f; S[kt][qt][r] = s; mx = fmaxf(mx, s); }
        }
        mx = fmaxf(mx, __shfl_xor(mx, 16)); mx = fmaxf(mx, __shfl_xor(mx, 32));
        float sum = 0.f;
#pragma unroll
        for (int kt = 0; kt < 12; ++kt)
#pragma unroll
            for (int r = 0; r < 4; ++r) { const float p = __expf(S[kt][qt][r] - mx); S[kt][qt][r] = p; sum += p; }
        sum += __shfl_xor(sum, 16); sum += __shfl_xor(sum, 32);
        sum += __expf(sink - mx);
        inv[qt] = 1.0f / sum;
    }
    f32x4 O[4][2];
#pragma unroll
    for (int dt = 0; dt < 4; ++dt) { O[dt][0] = (f32x4){0.f, 0.f, 0.f, 0.f}; O[dt][1] = (f32x4){0.f, 0.f, 0.f, 0.f}; }
#pragma unroll
    for (int kp = 0; kp < 6; ++kp) {
        bf16x8 Pf[2];
#pragma unroll
        for (int qt = 0; qt < 2; ++qt) {
            u32x4 w; const f32x4 a = S[2 * kp][qt], bq = S[2 * kp + 1][qt];
            w.x = cvt_pk_bf16(a[0], a[1]); w.y = cvt_pk_bf16(a[2], a[3]); w.z = cvt_pk_bf16(bq[0], bq[1]); w.w = cvt_pk_bf16(bq[2], bq[3]);
            Pf[qt] = __builtin_bit_cast(bf16x8, w);
        }
#pragma unroll
        for (int dt = 0; dt < 4; ++dt) {
            const LAS bf16_t* vp = VL + (16 * dt + l16) * VP + 32 * kp + 4 * fq;
            const u32x2 lo = *(const LAS u32x2*)vp, hi = *(const LAS u32x2*)(vp + 16);
            u32x4 w; w.x = lo.x; w.y = lo.y; w.z = hi.x; w.w = hi.y;
            const bf16x8 Vf = __builtin_bit_cast(bf16x8, w);
            O[dt][0] = __builtin_amdgcn_mfma_f32_16x16x32_bf16(Vf, Pf[0], O[dt][0], 0, 0, 0);
            O[dt][1] = __builtin_amdgcn_mfma_f32_16x16x32_bf16(Vf, Pf[1], O[dt][1], 0, 0, 0);
        }
    }
#pragma unroll
    for (int qt = 0; qt < 2; ++qt)
#pragma unroll
        for (int dt = 0; dt < 4; ++dt) {
            const f32x4 o = O[dt][qt] * inv[qt];
            u32x2 w; w.x = cvt_pk_bf16(o[0], o[1]); w.y = cvt_pk_bf16(o[2], o[3]);
            *(u32x2*)(MIX + (size_t)(qtok0 + 32 * qh + 16 * qt + l16) * DM + h * 64 + 16 * dt + 4 * fq) = w;
        }
}

template <int CTRL> __device__ __forceinline__ float dpp_shr(float idv, float v) {
    return __int_as_float(__builtin_amdgcn_update_dpp(__float_as_int(idv), __float_as_int(v), CTRL, 0xf, 0xf, false));
}
constexpr int XSP = 72;
constexpr int LRU_WAVE_BYTES = 10240;
struct LruP { const bf16_t* Z; bf16_t* MIX; const bf16_t* WaT; const bf16_t* WxT; const float *conv_w, *conv_b, *ba, *bx, *lam, *state_conv, *state_h; float *CP, *CH, *out; };
template <bool PASSC>
__device__ __forceinline__ void lru_unit(LAS unsigned char* lds, const LruP& P, int unit) {
    const int tid = threadIdx.x, lane = tid & 63, wave = __builtin_amdgcn_readfirstlane(tid >> 6), l16 = lane & 15, fq = lane >> 4;
    const bool samp = unit >= 1024;
    const int b = samp ? unit - 1024 : unit >> 7, c = samp ? 0 : unit & 127;
    const int tok0 = samp ? MP + b * 64 : b * 8192 + c * 64;
    const int ch0 = wave * 64;
    LAS bf16_t* XS = (LAS bf16_t*)(lds + wave * LRU_WAVE_BYTES);
    LAS float* HS = (LAS float*)(lds + wave * LRU_WAVE_BYTES + 9728);
#pragma unroll
    for (int i = 0; i < 9; ++i) {
        const int p = lane + 64 * i;
        if (p < 536) {
            const int r = p >> 3, seg = p & 7, tr = r - 3;
            u32x4 v = {0u, 0u, 0u, 0u};
            if (tr >= 0 || (!samp && c > 0)) v = *(const u32x4*)(P.Z + (size_t)(tok0 + tr) * NIN + 768 + ch0 + seg * 8);
            else if (samp) {
                const float* s = P.state_conv + ((size_t)(b * 3 + r) * 512 + ch0 + seg * 8);
                const f32x4 a0 = *(const f32x4*)s, a1 = *(const f32x4*)(s + 4);
                v.x = cvt_pk_bf16(a0[0], a0[1]); v.y = cvt_pk_bf16(a0[2], a0[3]); v.z = cvt_pk_bf16(a1[0], a1[1]); v.w = cvt_pk_bf16(a1[2], a1[3]);
            }
            *(LAS u32x4*)(XS + r * XSP + seg * 8) = v;
        }
    }
    if (PASSC) {
        float hst = 0.f;
        if (samp) hst = P.state_h[b * 512 + ch0 + lane];
        else {
            const float* cp = P.CP + (size_t)(b * 128) * 512 + ch0 + lane; const float* chp = P.CH + (size_t)(b * 128) * 512 + ch0 + lane;
#pragma unroll 8
            for (int cc = 0; cc < c; ++cc) hst = cp[(size_t)cc * 512] * hst + chp[(size_t)cc * 512];
        }
        HS[lane] = hst;
    }
    bf16x8 Xf[4][2];
#pragma unroll
    for (int ks = 0; ks < 2; ++ks) {
        const int chl = 32 * ks + 8 * fq;
        float cw[4][8], cb[8];
#pragma unroll
        for (int j = 0; j < 4; ++j) { const f32x4 a0 = *(const f32x4*)(P.conv_w + j * 512 + ch0 + chl), a1 = *(const f32x4*)(P.conv_w + j * 512 + ch0 + chl + 4);
#pragma unroll
            for (int e = 0; e < 4; ++e) { cw[j][e] = a0[e]; cw[j][4 + e] = a1[e]; } }
        { const f32x4 a0 = *(const f32x4*)(P.conv_b + ch0 + chl), a1 = *(const f32x4*)(P.conv_b + ch0 + chl + 4);
#pragma unroll
            for (int e = 0; e < 4; ++e) { cb[e] = a0[e]; cb[4 + e] = a1[e]; } }
#pragma unroll
        for (int tt = 0; tt < 4; ++tt) {
            float xc[8];
#pragma unroll
            for (int e = 0; e < 8; ++e) xc[e] = cb[e];
#pragma unroll
            for (int j = 0; j < 4; ++j) {
                const u32x4 xv = *(const LAS u32x4*)(XS + (16 * tt + l16 + j) * XSP + chl);
                xc[0] += cw[j][0] * __uint_as_float(xv.x << 16); xc[1] += cw[j][1] * __uint_as_float(xv.x & 0xffff0000u);
                xc[2] += cw[j][2] * __uint_as_float(xv.y << 16); xc[3] += cw[j][3] * __uint_as_float(xv.y & 0xffff0000u);
                xc[4] += cw[j][4] * __uint_as_float(xv.z << 16); xc[5] += cw[j][5] * __uint_as_float(xv.z & 0xffff0000u);
                xc[6] += cw[j][6] * __uint_as_float(xv.w << 16); xc[7] += cw[j][7] * __uint_as_float(xv.w & 0xffff0000u);
            }
            u32x4 w; w.x = cvt_pk_bf16(xc[0], xc[1]); w.y = cvt_pk_bf16(xc[2], xc[3]); w.z = cvt_pk_bf16(xc[4], xc[5]); w.w = cvt_pk_bf16(xc[6], xc[7]);
            Xf[tt][ks] = __builtin_bit_cast(bf16x8, w);
        }
    }
#pragma unroll 1
    for (int ct = 0; ct < 4; ++ct) {
        const int chq = ch0 + 16 * ct + 4 * fq;
        f32x4 ga[4], gx[4];
#pragma unroll
        for (int tt = 0; tt < 4; ++tt) { ga[tt] = (f32x4){0.f, 0.f, 0.f, 0.f}; gx[tt] = (f32x4){0.f, 0.f, 0.f, 0.f}; }
#pragma unroll
        for (int ks = 0; ks < 2; ++ks) {
            const size_t wo = (size_t)wave * 4096 + (size_t)(16 * ct + l16) * 64 + 32 * ks + 8 * fq;
            const bf16x8 wa = *(const bf16x8*)(P.WaT + wo), wx = *(const bf16x8*)(P.WxT + wo);
#pragma unroll
            for (int tt = 0; tt < 4; ++tt) {
                ga[tt] = __builtin_amdgcn_mfma_f32_16x16x32_bf16(wa, Xf[tt][ks], ga[tt], 0, 0, 0);
                gx[tt] = __builtin_amdgcn_mfma_f32_16x16x32_bf16(wx, Xf[tt][ks], gx[tt], 0, 0, 0);
            }
        }
        const f32x4 vba = *(const f32x4*)(P.ba + chq), vbx = *(const f32x4*)(P.bx + chq), vlam = *(const f32x4*)(P.lam + chq), vcb = *(const f32x4*)(P.conv_b + chq);
        f32x4 vcw[4];
#pragma unroll
        for (int j = 0; j < 4; ++j) vcw[j] = *(const f32x4*)(P.conv_w + j * 512 + chq);
        f32x4 c8;
#pragma unroll
        for (int r = 0; r < 4; ++r) c8[r] = -8.0f * log1pf(expf(-vlam[r]));
        f32x4 hc = {0.f, 0.f, 0.f, 0.f}, ptot = {1.f, 1.f, 1.f, 1.f};
        if (PASSC) hc = *(const LAS f32x4*)(HS + 16 * ct + 4 * fq);
#pragma unroll
        for (int tt = 0; tt < 4; ++tt) {
            f32x4 xcv = vcb;
#pragma unroll
            for (int j = 0; j < 4; ++j) {
                const u32x2 xv = *(const LAS u32x2*)(XS + (16 * tt + l16 + j) * XSP + 16 * ct + 4 * fq);
                xcv[0] += vcw[j][0] * __uint_as_float(xv.x << 16); xcv[1] += vcw[j][1] * __uint_as_float(xv.x & 0xffff0000u);
                xcv[2] += vcw[j][2] * __uint_as_float(xv.y << 16); xcv[3] += vcw[j][3] * __uint_as_float(xv.y & 0xffff0000u);
            }
            f32x4 hv;
#pragma unroll
            for (int r = 0; r < 4; ++r) {
                const float rr = fast_sigmoid(ga[tt][r] + vba[r]), ii = fast_sigmoid(gx[tt][r] + vbx[r]);
                const float la = c8[r] * rr;
                float Pv = __expf(la);
                float Hv = sqrtf(-expm1f(2.0f * la)) * (ii * xcv[r]);
                { const float p1 = dpp_shr<0x111>(1.f, Pv), h1 = dpp_shr<0x111>(0.f, Hv); Hv = Pv * h1 + Hv; Pv = p1 * Pv; }
                { const float p1 = dpp_shr<0x112>(1.f, Pv), h1 = dpp_shr<0x112>(0.f, Hv); Hv = Pv * h1 + Hv; Pv = p1 * Pv; }
                { const float p1 = dpp_shr<0x114>(1.f, Pv), h1 = dpp_shr<0x114>(0.f, Hv); Hv = Pv * h1 + Hv; Pv = p1 * Pv; }
                { const float p1 = dpp_shr<0x118>(1.f, Pv), h1 = dpp_shr<0x118>(0.f, Hv); Hv = Pv * h1 + Hv; Pv = p1 * Pv; }
                const float hval = Pv * hc[r] + Hv;
                hv[r] = hval;
                hc[r] = __shfl(hval, (lane & 48) | 15);
                if (!PASSC) ptot[r] *= __shfl(Pv, (lane & 48) | 15);
            }
            if (PASSC) {
                const size_t tok = (size_t)(tok0 + 16 * tt + l16);
                const u32x2 gw = *(const u32x2*)(P.Z + tok * NIN + 1280 + chq);
                f32x4 gb; gb[0] = __uint_as_float(gw.x << 16); gb[1] = __uint_as_float(gw.x & 0xffff0000u); gb[2] = __uint_as_float(gw.y << 16); gb[3] = __uint_as_float(gw.y & 0xffff0000u);
                f32x4 y;
#pragma unroll
                for (int r = 0; r < 4; ++r) { const float x = gb[r]; const float yy = 0.7978845608028654f * (x + 0.044715f * x * x * x); y[r] = hv[r] * x * fast_sigmoid(2.0f * yy); }
                u32x2 w; w.x = cvt_pk_bf16(y[0], y[1]); w.y = cvt_pk_bf16(y[2], y[3]);
                *(u32x2*)(P.MIX + tok * DM + 512 + chq) = w;
            }
        }
        if (l16 == 0) {
            if (PASSC) {
                if (samp) *(f32x4*)(P.out + O_NHS + b * 512 + chq) = hc;
                else if (c == 127) *(f32x4*)(P.out + O_NHP + b * 512 + chq) = hc;
            } else {
                *(f32x4*)(P.CP + (size_t)(b * 128 + c) * 512 + chq) = ptot;
                *(f32x4*)(P.CH + (size_t)(b * 128 + c) * 512 + chq) = hc;
            }
        }
    }
}

#ifndef PHMASK
#define PHMASK 0xffff
#endif
constexpr int LDS_BYTES = 147456;
__global__ void __launch_bounds__(512, 2) fwd(Args a) {
    extern __shared__ __attribute__((aligned(16))) unsigned char lds_raw[];
    LAS unsigned char* lds = (LAS unsigned char*)lds_raw;
    cg::grid_group grid = cg::this_grid();
    const int tid = threadIdx.x, lane = tid & 63, wave = __builtin_amdgcn_readfirstlane(tid >> 6);
    const int G = gridDim.x, bx = blockIdx.x;
    const int gw = bx * 8 + wave, NGW = G * 8;
    unsigned char* ws = a.ws;
    float* out = a.out;
    bf16_t* W1GU = (bf16_t*)(ws + WS_W1GU); bf16_t* W1D = (bf16_t*)(ws + WS_W1D); bf16_t* WIN = (bf16_t*)(ws + WS_WIN); bf16_t* WOUT = (bf16_t*)(ws + WS_WOUT);
    bf16_t* W2GU = (bf16_t*)(ws + WS_W2GU); bf16_t* W2D = (bf16_t*)(ws + WS_W2D); bf16_t* WPG = (bf16_t*)(ws + WS_WPG); bf16_t* WPLE = (bf16_t*)(ws + WS_WPLE);
    bf16_t* WAT = (bf16_t*)(ws + WS_LRUW); bf16_t* WXT = WAT + 8 * 4096;
    float* ROPE = (float*)(ws + WS_ROPE); float* CP = (float*)(ws + WS_CP); float* CH = (float*)(ws + WS_CH);
    bf16_t* XB = (bf16_t*)(ws + WS_XB); bf16_t* MIX = XB; bf16_t* ACT = (bf16_t*)(ws + WS_ACT); bf16_t* PE = ACT;
    bf16_t* H1 = (bf16_t*)(ws + WS_H1); bf16_t* H3 = H1; bf16_t* Z = (bf16_t*)(ws + WS_Z); bf16_t* H2 = Z; bf16_t* PB = (bf16_t*)(ws + WS_PB);
    float* T1 = out;

    #if PHMASK & (1<<0)
    {
        LAS float* scr = (LAS float*)(lds + wave * 16384);
        constexpr int I_GU = 16 * 88, I_D = 44 * 32, I_IN = 16 * 56, I_SQ = 16 * 32, I_PLE = 4 * 32, I_LRU = 2;
        constexpr int NITEMS = 4 * I_GU + 2 * I_D + I_IN + 2 * I_SQ + I_PLE + 16 * I_LRU;
        for (int it = gw; it < NITEMS; it += NGW) {
            int r = it;
            if (r < I_GU) { transpose_matrix_item(a.in[8], DM, FF, W1GU, 1, r, scr, lane); continue; } r -= I_GU;
            if (r < I_GU) { transpose_matrix_item(a.in[9], DM, FF, W1GU, 2, r, scr, lane); continue; } r -= I_GU;
            if (r < I_GU) { transpose_matrix_item(a.in[25], DM, FF, W2GU, 1, r, scr, lane); continue; } r -= I_GU;
            if (r < I_GU) { transpose_matrix_item(a.in[26], DM, FF, W2GU, 2, r, scr, lane); continue; } r -= I_GU;
            if (r < I_D) { transpose_matrix_item(a.in[10], FF, DM, W1D, 0, r, scr, lane); continue; } r -= I_D;
            if (r < I_D) { transpose_matrix_item(a.in[27], FF, DM, W2D, 0, r, scr, lane); continue; } r -= I_D;
            if (r < I_IN) { transpose_matrix_item(a.in[13], DM, NIN, WIN, 0, r, scr, lane); continue; } r -= I_IN;
            if (r < I_SQ) { transpose_matrix_item(a.in[22], DM, DM, WOUT, 0, r, scr, lane); continue; } r -= I_SQ;
            if (r < I_SQ) { transpose_matrix_item(a.in[31], DM, DM, WPG, 0, r, scr, lane); continue; } r -= I_SQ;
            if (r < I_PLE) { transpose_matrix_item(a.in[30], PLE, DM, WPLE, 0, r, scr, lane); continue; } r -= I_PLE;
            { const int blk = (r >> 1) & 7, which = r >> 4, sub = r & 1;
              transpose_matrix_item(a.in[which ? 19 : 17] + blk * 4096, 64, 64, (which ? WXT : WAT) + blk * 4096, 0, sub, scr, lane); }
        }
        const size_t gt = (size_t)bx * 512 + tid, gs = (size_t)G * 512;
        for (size_t i = gt; i < 8192 * 8; i += gs) {
            const int pos = (int)(i >> 3), j = (int)(i & 7);
            const float inv = powf(500000.0f, -(float)j * 0.125f);
            const float ang = (float)pos * inv;
            ROPE[pos * 16 + j] = cosf(ang); ROPE[pos * 16 + 8 + j] = sinf(ang);
        }
        for (size_t i = gt; i < (size_t)MT * DM / 8; i += gs) {
            const size_t e = i * 8;
            const float* src = (e < (size_t)MP * DM) ? a.in[0] + e : a.in[1] + (e - (size_t)MP * DM);
            const f32x4 v0 = *(const f32x4*)src, v1 = *(const f32x4*)(src + 4);
            u32x4 w; w.x = cvt_pk_bf16(v0[0], v0[1]); w.y = cvt_pk_bf16(v0[2], v0[3]); w.z = cvt_pk_bf16(v1[0], v1[1]); w.w = cvt_pk_bf16(v1[2], v1[3]);
            *(u32x4*)(XB + e) = w;
        }
        for (size_t i = gt; i < (size_t)MT * PLE / 8; i += gs) {
            const size_t e = i * 8;
            const float* src = (e < (size_t)MP * PLE) ? a.in[2] + e : a.in[3] + (e - (size_t)MP * PLE);
            const f32x4 v0 = *(const f32x4*)src, v1 = *(const f32x4*)(src + 4);
            u32x4 w; w.x = cvt_pk_bf16(v0[0], v0[1]); w.y = cvt_pk_bf16(v0[2], v0[3]); w.z = cvt_pk_bf16(v1[0], v1[1]); w.w = cvt_pk_bf16(v1[2], v1[3]);
            *(u32x4*)(PB + e) = w;
        }
        for (size_t i = gt; i < 8 * 64 * 128; i += gs) {
            const int b = (int)(i >> 13), rem = (int)(i & 8191);
            out[O_NKS + (size_t)b * 16384 + rem] = a.in[4][(size_t)b * 16384 + 8192 + rem];
            out[O_NVS + (size_t)b * 16384 + rem] = a.in[5][(size_t)b * 16384 + 8192 + rem];
        }
    }
#endif
    grid.sync();
    #if PHMASK & (1<<1)
    { pg8::Gemm g{XB, W1GU, MT, 2 * FF, DM}; pg8::StaticOrder S; S.init(MT, 2 * FF, G, bx); EpiSwiglu E{ACT};
      pg8::gemm_phase<EpiSwiglu, pg8::StaticOrder, true, true>(lds, g, S, E); }
#endif
    grid.sync();
    #if PHMASK & (1<<2)
    { pg8::Gemm g{ACT, W1D, MT, DM, FF}; pg8::StaticOrder S; S.init(MT, DM, G, bx); EpiResid E{a.in[0], a.in[1], T1, 0.5f};
      pg8::gemm_phase<EpiResid, pg8::StaticOrder, true, true>(lds, g, S, E); }
#endif
    grid.sync();
    #if PHMASK & (1<<3)
    for (int m = gw; m < MT; m += NGW) ln_row(T1 + (size_t)m * DM, a.in[11], a.in[12], H1 + (size_t)m * DM, lane);
#endif
    grid.sync();
    #if PHMASK & (1<<4)
    { pg8::Gemm g{H1, WIN, MT, NIN, DM}; pg8::StaticOrder S; S.init(MT, NIN, G, bx); EpiWin E{Z, ROPE, out};
      pg8::gemm_phase<EpiWin, pg8::StaticOrder, true, true>(lds, g, S, E); }
#endif
    grid.sync();
    LruP LP{Z, MIX, WAT, WXT, a.in[15], a.in[16], a.in[18], a.in[20], a.in[21], a.in[6], a.in[7], CP, CH, out};
    #if PHMASK & (1<<5)
    {
        const size_t gt = (size_t)bx * 512 + tid, gs = (size_t)G * 512;
        for (size_t i = gt; i < 2 * 8 * 128 * 256; i += gs) {
            const int col = (int)(i & 255), j = (int)((i >> 8) & 127), b = (int)((i >> 15) & 7), set = (int)(i >> 18);
            const int row = set ? (j >= 64 ? MP + b * 64 + (j - 64) : -1) : (b * 8192 + 8064 + j);
            if (row >= 0) {
                const float v = bf2f(Z[(size_t)row * NIN + 512 + col]);
                const size_t o = (col < 128) ? (set ? O_NKS : O_NKP) : (set ? O_NVS : O_NVP);
                out[o + (size_t)(b * 128 + j) * 128 + (col & 127)] = v;
            }
        }
        for (size_t i = gt; i < 2 * 8 * 3 * 512; i += gs) {
            const int ch = (int)(i & 511), r = (int)(i >> 9), j = r % 3, b = (r / 3) & 7, set = r / 24;
            const int row = set ? (MP + b * 64 + 61 + j) : (b * 8192 + 8189 + j);
            out[(set ? O_NCS : O_NCP) + (size_t)(b * 3 + j) * 512 + ch] = bf2f(Z[(size_t)row * NIN + 768 + ch]);
        }
    }
    for (int it = bx; it < 2064 + 1024; it += G) {
        if (it < 2064) attn_unit(lds, Z, MIX, a.in[4], a.in[5], a.in[14], it);
        else { __syncthreads(); lru_unit<false>(lds, LP, it - 2064); }
    }
#endif
    grid.sync();
    #if PHMASK & (1<<6)
    for (int it = bx; it < 1032; it += G) lru_unit<true>(lds, LP, it);
#endif
    grid.sync();
    #if PHMASK & (1<<7)
    { pg8::Gemm g{MIX, WOUT, MT, DM, DM}; pg8::StaticOrder S; S.init(MT, DM, G, bx); EpiResid E{T1, T1 + (size_t)MP * DM, T1, 1.0f};
      pg8::gemm_phase<EpiResid, pg8::StaticOrder, true, true>(lds, g, S, E); }
#endif
    grid.sync();
    #if PHMASK & (1<<8)
    for (int m = gw; m < MT; m += NGW) ln_row(T1 + (size_t)m * DM, a.in[23], a.in[24], H2 + (size_t)m * DM, lane);
#endif
    grid.sync();
    #if PHMASK & (1<<9)
    { pg8::Gemm g{H2, W2GU, MT, 2 * FF, DM}; pg8::StaticOrder S; S.init(MT, 2 * FF, G, bx); EpiSwiglu E{ACT};
      pg8::gemm_phase<EpiSwiglu, pg8::StaticOrder, true, true>(lds, g, S, E); }
#endif
    grid.sync();
    #if PHMASK & (1<<10)
    { pg8::Gemm g{ACT, W2D, MT, DM, FF}; pg8::StaticOrder S; S.init(MT, DM, G, bx); EpiResid E{T1, T1 + (size_t)MP * DM, T1, 0.5f};
      pg8::gemm_phase<EpiResid, pg8::StaticOrder, true, true>(lds, g, S, E); }
#endif
    grid.sync();
    #if PHMASK & (1<<11)
    for (int m = gw; m < MT; m += NGW) ln_row(T1 + (size_t)m * DM, a.in[28], a.in[29], H3 + (size_t)m * DM, lane);
    __syncthreads();
#endif
#if PHMASK & (1<<13)
    { pg8::Gemm g{PB, WPLE, MT, DM, PLE}; pg8::StaticOrder S; S.init(MT, DM, G, bx); EpiBf16 E{PE, DM};
      pg8::gemm_phase<EpiBf16, pg8::StaticOrder, true, true>(lds, g, S, E); }
#endif
    grid.sync();
    #if PHMASK & (1<<12)
    { pg8::Gemm g{H3, WPG, MT, DM, DM}; pg8::StaticOrder S; S.init(MT, DM, G, bx); EpiFinal E{T1, PE};
      pg8::gemm_phase<EpiFinal, pg8::StaticOrder, true, true>(lds, g, S, E); }
#endif
}

extern "C" void kernel_launch(void* const* d_in, const int* in_sizes, int n_in, void* d_out, int out_size, void* d_ws, size_t ws_size, hipStream_t stream) {
    static int grid = 0;
    if (grid == 0) {
        if (n_in != 32 || ws_size < WS_END) { fprintf(stderr, "kernel_launch: unexpected n_in %d / ws %zu\n", n_in, ws_size); grid = -1; return; }
        int dev = 0, cus = 0, per_cu = 0;
        (void)hipGetDevice(&dev);
        (void)hipDeviceGetAttribute(&cus, hipDeviceAttributeMultiprocessorCount, dev);
        (void)hipFuncSetAttribute((const void*)fwd, hipFuncAttributeMaxDynamicSharedMemorySize, LDS_BYTES);
        (void)hipOccupancyMaxActiveBlocksPerMultiprocessor(&per_cu, (const void*)fwd, 512, LDS_BYTES);
        if (per_cu < 1) per_cu = 1;
        grid = cus * per_cu;
    }
    if (grid < 0) return;
    Args a{};
    for (int i = 0; i < 32; ++i) a.in[i] = (const float*)d_in[i];
    a.out = (float*)d_out; a.ws = (unsigned char*)d_ws;
    void* args[] = {&a};
    hipError_t e = hipLaunchCooperativeKernel((const void*)fwd, dim3(grid), dim3(512), args, LDS_BYTES, stream);
    if (e != hipSuccess) fprintf(stderr, "cooperative launch failed: %s (grid %d)\n", hipGetErrorString(e), grid);
}
```

```cpp
#include <hip/hip_runtime.h>
#include <hip/hip_cooperative_groups.h>
#include <cstdio>
#include <cstdint>
namespace cg = cooperative_groups;

#define LAS __attribute__((address_space(3)))
typedef unsigned short bf16_t;
typedef short bf16x8 __attribute__((ext_vector_type(8)));
typedef float f32x4 __attribute__((ext_vector_type(4)));
typedef float f32x2 __attribute__((ext_vector_type(2)));
typedef unsigned u32x4 __attribute__((ext_vector_type(4)));
typedef unsigned u32x2 __attribute__((ext_vector_type(2)));

constexpr int MP = 65536, MS = 512, MT = MP + MS;
constexpr int DM = 1024, FF = 2816, NIN = 1792, PLE = 256;
constexpr float ALPHA = 1.189207115002721f;
constexpr float LN_EPS = 1e-5f;
constexpr size_t O_Y = 0, O_NKP = 67633152, O_NVP = 67764224, O_NCP = 67895296, O_NHP = 67907584,
                 O_NKS = 67911680, O_NVS = 68042752, O_NCS = 68173824, O_NHS = 68186112;
constexpr size_t MiB = 1u << 20;
constexpr size_t WS_W1GU = 0, WS_W1D = 12 * MiB, WS_WIN = 18 * MiB, WS_WOUT = 22 * MiB, WS_W2GU = 24 * MiB, WS_W2D = 36 * MiB,
                 WS_WPG = 42 * MiB, WS_WPLE = 44 * MiB, WS_LRUW = 45 * MiB, WS_ROPE = 46 * MiB, WS_CP = 47 * MiB, WS_CH = 49 * MiB,
                 WS_STATS = 52 * MiB  , STATS_ZERO_BYTES = 2 * MiB, WS_TICK_OFF = 1700 * 1024, WS_ACCB = 56 * MiB  , WS_BAR_OFF = 1792 * 1024  ,
                 WS_XB = 64 * MiB  , WS_ACT = 194 * MiB  , WS_H1 = 550 * MiB  ,
                 WS_Z = 680 * MiB  , WS_PB = 906 * MiB, WS_END = 940 * MiB;

namespace pg8 {
constexpr int BM = 256, BK = 64, HALF = 128, HTB = HALF * BK * 2, STAGE_BYTES = 8 * HTB, NXCD = 8, WGM = 8;
__host__ __device__ __forceinline__ int lds_byte(int r, int c) { const int st = (r >> 4) * 2 + (c >> 5), rr = r & 15, cc = c & 31, ob = rr * 64 + cc * 2; return st * 1024 + (ob ^ (((ob >> 9) & 1) << 5)); }
__host__ __device__ __forceinline__ void stage_rc(int b, int& R, int& C) { const int st = b / 1024, sb = b % 1024, swz = sb ^ (((sb >> 9) & 1) << 5); R = (st >> 1) * 16 + swz / 64; C = (st & 1) * 32 + (swz % 64) / 2; }
__host__ __device__ __forceinline__ int perm32(int rho) { const int n = rho >> 4, i = rho & 15; return 8 * (i >> 2) + 4 * n + (i & 3); }
struct Unit { int pm, pn, ks; };
struct Gemm { const bf16_t* A; const bf16_t* Bt; int M, N, K, Ks; };
struct StaticOrder {
    int nM, nN, nwg, G, c;
    __host__ __device__ void init(int M, int N, int G_, int c_) { nM = M / BM; nN = N / BM; nwg = nM * nN; G = G_; c = c_; }
    __host__ __device__ bool next(int i, Unit& u) const {
        const long L = (long)i * G + c; if (L >= nwg) return false;
        int wgid = (int)L; { const int q = nwg / NXCD, r = nwg % NXCD, xcd = wgid % NXCD, off = wgid / NXCD; wgid = (xcd < r ? xcd * (q + 1) : r * (q + 1) + (xcd - r) * q) + off; }
        const int nig = WGM * nN, gid = wgid / nig, fm = gid * WGM, gsz = (nM - fm) < WGM ? (nM - fm) : WGM;
        u.pm = fm + ((wgid % nig) % gsz); u.pn = (wgid % nig) / gsz; u.ks = 0; return true;
    }
    __device__ __forceinline__ void a_ready(const Unit&) const {}
    __device__ __forceinline__ void done(const Unit&) const {}
};
struct SplitOrder {
    int nN, S, nu, G, c;
    __host__ __device__ void init(int N, int S_, int G_, int c_) { nN = N / BM; S = S_; nu = 2 * nN * S; G = G_; c = c_; }
    __host__ __device__ bool next(int i, Unit& u) const {
        const int L = i * G + c; if (L >= nu) return false;
        const int t = L / S; u.ks = L % S; u.pn = t % nN; u.pm = 256 + t / nN; return true;
    }
    __device__ __forceinline__ void a_ready(const Unit&) const {}
    __device__ __forceinline__ void done(const Unit&) const {}
};
__device__ __forceinline__ unsigned cvt_pk_bf16(float lo, float hi) { unsigned r; asm volatile("v_cvt_pk_bf16_f32 %0, %1, %2" : "=v"(r) : "v"(lo), "v"(hi)); return r; }

template <class Epi, class Sched, bool ALIGN_EPI = false, bool SP2 = false>
__device__ __forceinline__ void gemm_phase(LAS unsigned char* lds, const Gemm g, const Sched& S, const Epi& E) {
    int tid_op = threadIdx.x; asm volatile("" : "+v"(tid_op));
    const int tid = tid_op, wid = __builtin_amdgcn_readfirstlane(tid >> 6), lane = tid & 63, wr = wid >> 2, wc = wid & 3, fr = lane & 15, fq = lane >> 4;
    int Kop = g.K; asm volatile("" : "+s"(Kop));
    int Ksop = g.Ks; asm volatile("" : "+s"(Ksop));
    const int K = Kop, nt = Ksop / BK;
    const size_t sstep = (size_t)Ksop * 2;
    unsigned voffA[2], voffB[2];
#pragma unroll
    for (int i = 0; i < 2; ++i) { int R, C; stage_rc(tid * 16 + i * 8192, R, C); const int Rb = Epi::PERM ? ((R & ~31) + perm32(R & 31)) : R;
        voffA[i] = (unsigned)(R * K + C) * 2u; voffB[i] = (unsigned)(Rb * K + C) * 2u; }
    const size_t kstep = (size_t)(BK * 2);
    const size_t hstep = (size_t)HALF * K * 2;
    const size_t tstep = 2 * hstep;
    const unsigned ldsw = (unsigned)wid * 1024u;
    const int aoff = lds_byte(wr * 64 + fr, fq * 8), boff = lds_byte(wc * 32 + fr, fq * 8);
#define PG8_SA(b, h) (((b) * 2 + (h)) * HTB)
#define PG8_SB(b, h) ((4 + (b) * 2 + (h)) * HTB)
#define PG8_STAGE(bufoff, gbase, voff) do { _Pragma("unroll") for (int _i = 0; _i < 2; ++_i) \
        __builtin_amdgcn_global_load_lds((const unsigned*)((const char*)(gbase) + (voff)[_i]), (LAS unsigned*)(lds + (bufoff) + ldsw + _i * 8192), 16, 0, 0); } while (0)
#define PG8_LDA(dst, b, h) do { _Pragma("unroll") for (int m = 0; m < 4; ++m) _Pragma("unroll") for (int k = 0; k < 2; ++k) dst[m][k] = *(const LAS bf16x8*)(lds + PG8_SA(b, h) + aoff + m * 2048 + k * 1024); } while (0)
#define PG8_LDB(dst, b, h) do { _Pragma("unroll") for (int n = 0; n < 2; ++n) _Pragma("unroll") for (int k = 0; k < 2; ++k) dst[n][k] = *(const LAS bf16x8*)(lds + PG8_SB(b, h) + boff + n * 2048 + k * 1024); } while (0)
#define PG8_MMA(ai, bj, At, Bt) do { __builtin_amdgcn_s_setprio(1); _Pragma("unroll") for (int m = 0; m < 4; ++m) _Pragma("unroll") for (int n = 0; n < 2; ++n) _Pragma("unroll") for (int k = 0; k < 2; ++k) \
        acc[ai][bj][m][n] = __builtin_amdgcn_mfma_f32_16x16x32_bf16(Bt[n][k], At[m][k], acc[ai][bj][m][n], 0, 0, 0); __builtin_amdgcn_s_setprio(0); } while (0)
#define PG8_WAIT_V(n) asm volatile("s_waitcnt vmcnt(" #n ")" ::: "memory")
#define PG8_WAIT_L(n) asm volatile("s_waitcnt lgkmcnt(" #n ")" ::: "memory")
#define PG8_BAR __builtin_amdgcn_s_barrier()
#define PG8_SCHED __builtin_amdgcn_sched_barrier(0)
    Unit cur, nxt; int ui = 0;
    if (!S.next(0, cur)) return;
    f32x4 acc[2][2][4][2];
#pragma unroll
    for (int a = 0; a < 2; ++a)
#pragma unroll
        for (int b = 0; b < 2; ++b)
#pragma unroll
            for (int m = 0; m < 4; ++m)
#pragma unroll
                for (int n = 0; n < 2; ++n) acc[a][b][m][n] = (f32x4){0.f, 0.f, 0.f, 0.f};
    bf16x8 At[4][2], B0[2][2], B1[2][2];
    const char* cA = (const char*)g.A + (size_t)cur.pm * tstep + (size_t)cur.ks * sstep; const char* cB = (const char*)g.Bt + (size_t)cur.pn * tstep + (size_t)cur.ks * sstep;
    S.a_ready(cur);
    if constexpr (SP2) {
        PG8_STAGE(PG8_SB(0, 0), cB, voffB); PG8_STAGE(PG8_SB(0, 1), cB + hstep, voffB); PG8_STAGE(PG8_SA(0, 0), cA, voffA); PG8_STAGE(PG8_SA(0, 1), cA + hstep, voffA);
        if (wr == 1) PG8_BAR;
        PG8_WAIT_V(2); PG8_BAR;
        PG8_STAGE(PG8_SB(1, 0), cB + kstep, voffB); PG8_STAGE(PG8_SA(1, 0), cA + kstep, voffA); PG8_STAGE(PG8_SB(1, 1), cB + hstep + kstep, voffB);
        PG8_WAIT_V(6); PG8_BAR;
    } else {
        PG8_STAGE(PG8_SB(0, 0), cB, voffB); PG8_STAGE(PG8_SA(0, 0), cA, voffA); PG8_STAGE(PG8_SB(0, 1), cB + hstep, voffB); PG8_STAGE(PG8_SA(0, 1), cA + hstep, voffA);
        if (wr == 1) PG8_BAR;
        PG8_WAIT_V(4); PG8_BAR;
        PG8_STAGE(PG8_SB(1, 0), cB + kstep, voffB); PG8_STAGE(PG8_SA(1, 0), cA + kstep, voffA); PG8_STAGE(PG8_SB(1, 1), cB + hstep + kstep, voffB);
        PG8_WAIT_V(6); PG8_BAR;
    }
    for (;;) {
        const bool has_next = S.next(ui + 1, nxt);
        const char* nA = has_next ? (const char*)g.A + (size_t)nxt.pm * tstep + (size_t)nxt.ks * sstep : cA; const char* nB = has_next ? (const char*)g.Bt + (size_t)nxt.pn * tstep + (size_t)nxt.ks * sstep : cB;
        for (int t = 0; t < nt; t += 2) {
            const bool last = (t == nt - 2);
            const char* a1 = cA + (size_t)(t + 1) * kstep;
            const char* a2 = last ? nA : cA + (size_t)(t + 2) * kstep; const char* b2 = last ? nB : cB + (size_t)(t + 2) * kstep;
            const char* a3 = a2 + kstep; const char* b3 = b2 + kstep;
            if (last && has_next) S.a_ready(nxt);
            if constexpr (SP2) {
            PG8_LDB(B0, 0, 0); PG8_LDB(B1, 0, 1); PG8_SCHED; PG8_LDA(At, 0, 0); PG8_STAGE(PG8_SA(1, 1), a1 + hstep, voffA);
            PG8_WAIT_V(8); PG8_WAIT_L(0); PG8_BAR; PG8_MMA(0, 0, At, B0); PG8_MMA(0, 1, At, B1); PG8_BAR; PG8_SCHED;
            PG8_LDA(At, 0, 1); PG8_STAGE(PG8_SB(0, 0), b2, voffB); PG8_STAGE(PG8_SB(0, 1), b2 + hstep, voffB); PG8_STAGE(PG8_SA(0, 0), a2, voffA);
            PG8_WAIT_V(8); PG8_WAIT_L(0); PG8_BAR; PG8_MMA(1, 0, At, B0); PG8_MMA(1, 1, At, B1); PG8_BAR; PG8_SCHED;
            PG8_LDB(B0, 1, 0); PG8_LDB(B1, 1, 1); PG8_SCHED; PG8_LDA(At, 1, 0); PG8_STAGE(PG8_SA(0, 1), a2 + hstep, voffA);
            PG8_WAIT_V(8); PG8_WAIT_L(0); PG8_BAR; PG8_MMA(0, 0, At, B0); PG8_MMA(0, 1, At, B1); PG8_BAR; PG8_SCHED;
            PG8_LDA(At, 1, 1); PG8_STAGE(PG8_SB(1, 0), b3, voffB); PG8_STAGE(PG8_SB(1, 1), b3 + hstep, voffB); PG8_STAGE(PG8_SA(1, 0), a3, voffA);
            PG8_WAIT_V(8); PG8_WAIT_L(0); PG8_BAR; PG8_MMA(1, 0, At, B0); PG8_MMA(1, 1, At, B1); PG8_BAR; PG8_SCHED;
            } else {
            PG8_LDB(B0, 0, 0); PG8_SCHED; PG8_LDA(At, 0, 0); PG8_STAGE(PG8_SA(1, 1), a1 + hstep, voffA);
            PG8_WAIT_L(8); PG8_BAR; PG8_WAIT_L(0); PG8_MMA(0, 0, At, B0); PG8_BAR; PG8_SCHED;
            PG8_LDB(B1, 0, 1); PG8_STAGE(PG8_SB(0, 0), b2, voffB);
            PG8_BAR; PG8_WAIT_L(0); PG8_MMA(0, 1, At, B1); PG8_BAR;
            PG8_LDA(At, 0, 1); PG8_STAGE(PG8_SA(0, 0), a2, voffA);
            PG8_BAR; PG8_WAIT_L(0); PG8_MMA(1, 0, At, B0); PG8_BAR; PG8_SCHED;
            PG8_STAGE(PG8_SB(0, 1), b2 + hstep, voffB);
            PG8_WAIT_V(6); PG8_BAR; PG8_MMA(1, 1, At, B1); PG8_BAR;
            PG8_LDB(B0, 1, 0); PG8_SCHED; PG8_LDA(At, 1, 0); PG8_STAGE(PG8_SA(0, 1), a2 + hstep, voffA);
            PG8_WAIT_L(8); PG8_BAR; PG8_WAIT_L(0); PG8_MMA(0, 0, At, B0); PG8_BAR; PG8_SCHED;
            PG8_LDB(B1, 1, 1); PG8_STAGE(PG8_SB(1, 0), b3, voffB);
            PG8_BAR; PG8_WAIT_L(0); PG8_MMA(0, 1, At, B1); PG8_BAR;
            PG8_LDA(At, 1, 1); PG8_STAGE(PG8_SA(1, 0), a3, voffA);
            PG8_BAR; PG8_WAIT_L(0); PG8_MMA(1, 0, At, B0); PG8_BAR; PG8_SCHED;
            PG8_STAGE(PG8_SB(1, 1), b3 + hstep, voffB);
            PG8_WAIT_V(6); PG8_BAR; PG8_MMA(1, 1, At, B1); PG8_BAR;
            }
        }
        if constexpr (ALIGN_EPI) { if (wr == 0) PG8_BAR; }
        E(acc, cur, wr, wc, fr, fq);
        if (!has_next) break;
#pragma unroll
        for (int a = 0; a < 2; ++a)
#pragma unroll
            for (int b = 0; b < 2; ++b)
#pragma unroll
                for (int m = 0; m < 4; ++m)
#pragma unroll
                    for (int n = 0; n < 2; ++n) acc[a][b][m][n] = (f32x4){0.f, 0.f, 0.f, 0.f};
        cur = nxt; cA = nA; cB = nB; ++ui;
        if constexpr (ALIGN_EPI) { if (wr == 1) PG8_BAR; }
    }
    PG8_WAIT_V(0);
    if constexpr (!ALIGN_EPI) { if (wr == 0) PG8_BAR; }
    PG8_BAR;
#undef PG8_SA
#undef PG8_SB
#undef PG8_STAGE
#undef PG8_LDA
#undef PG8_LDB
#undef PG8_MMA
#undef PG8_WAIT_V
#undef PG8_WAIT_L
#undef PG8_BAR
#undef PG8_SCHED
}
}
using pg8::cvt_pk_bf16;
using pg8::Unit;

__device__ __forceinline__ float fast_sigmoid(float x) { return __builtin_amdgcn_rcpf(1.0f + __expf(-x)); }

__device__ __forceinline__ void ln_stats(const float* ST, int row, float& mu, float& rstd) {
    const f32x2 sq = *(const f32x2*)(ST + 2 * (size_t)row);
    mu = sq[0] * (1.0f / DM); const float var = sq[1] * (1.0f / DM) - mu * mu; rstd = __builtin_amdgcn_rsqf(var + LN_EPS);
}
template <bool LN> struct EpiSwiglu {
    static constexpr bool PERM = true;
    bf16_t* O; const float* ST; const float* S; const float* C;
    __device__ __forceinline__ void operator()(const f32x4 (&acc)[2][2][4][2], const Unit& u, int wr, int wc, int fr, int fq) const {
        const int row0 = u.pm * 256 + wr * 64 + fr, col0 = u.pn * 128 + wc * 32 + 8 * fq, gc0 = u.pn * 256 + wc * 32 + 8 * fq;
        f32x4 sg0, sg1, su0, su1, cg0, cg1, cu0, cu1;
        if (LN) { sg0 = *(const f32x4*)(S + gc0); sg1 = *(const f32x4*)(S + gc0 + 4); su0 = *(const f32x4*)(S + gc0 + 128); su1 = *(const f32x4*)(S + gc0 + 132);
                  cg0 = *(const f32x4*)(C + gc0); cg1 = *(const f32x4*)(C + gc0 + 4); cu0 = *(const f32x4*)(C + gc0 + 128); cu1 = *(const f32x4*)(C + gc0 + 132); }
#pragma unroll
        for (int ai = 0; ai < 2; ++ai)
#pragma unroll
            for (int m = 0; m < 4; ++m) {
                const int row = row0 + ai * 128 + m * 16;
                f32x4 g0 = acc[ai][0][m][0], g1 = acc[ai][0][m][1], u0 = acc[ai][1][m][0], u1 = acc[ai][1][m][1];
                if (LN) { float mu, rstd; ln_stats(ST, row, mu, rstd);
                    g0 = (g0 - sg0 * mu) * rstd + cg0; g1 = (g1 - sg1 * mu) * rstd + cg1; u0 = (u0 - su0 * mu) * rstd + cu0; u1 = (u1 - su1 * mu) * rstd + cu1; }
                float v[8];
#pragma unroll
                for (int j = 0; j < 4; ++j) { v[j] = g0[j] * fast_sigmoid(g0[j]) * u0[j]; v[4 + j] = g1[j] * fast_sigmoid(g1[j]) * u1[j]; }
                u32x4 w; w.x = cvt_pk_bf16(v[0], v[1]); w.y = cvt_pk_bf16(v[2], v[3]); w.z = cvt_pk_bf16(v[4], v[5]); w.w = cvt_pk_bf16(v[6], v[7]);
                *(u32x4*)(O + (size_t)row * FF + col0) = w;
            }
    }
};
template <bool LN, bool HALF> struct EpiResid {
    static constexpr bool PERM = true;
    const bf16_t* RB; bf16_t* TB; const float* stIn; const float* gIn; const float* bIn; float* stOut;
    static constexpr float sacc = HALF ? 0.5f : 1.0f;
    __device__ __forceinline__ void operator()(const f32x4 (&acc)[2][2][4][2], const Unit& u, int wr, int wc, int fr, int fq) const {
        const int row0 = u.pm * 256 + wr * 64 + fr, col0 = u.pn * 256 + wc * 32 + 8 * fq;
#pragma unroll
        for (int ai = 0; ai < 2; ++ai)
#pragma unroll
            for (int m = 0; m < 4; ++m) {
                const int row = row0 + ai * 128 + m * 16;
                const size_t off = (size_t)row * DM + col0;
                float mu = 0.f, rstd = 1.f;
                if (LN) ln_stats(stIn, row, mu, rstd);
                float ps = 0.f, pq = 0.f;
#pragma unroll
                for (int bj = 0; bj < 2; ++bj) {
                    const u32x4 rw = *(const u32x4*)(RB + off + bj * 128);
                    f32x4 r0, r1;
                    r0[0] = __uint_as_float(rw.x << 16); r0[1] = __uint_as_float(rw.x & 0xffff0000u); r0[2] = __uint_as_float(rw.y << 16); r0[3] = __uint_as_float(rw.y & 0xffff0000u);
                    r1[0] = __uint_as_float(rw.z << 16); r1[1] = __uint_as_float(rw.z & 0xffff0000u); r1[2] = __uint_as_float(rw.w << 16); r1[3] = __uint_as_float(rw.w & 0xffff0000u);
                    if (LN) { const f32x4 g0 = *(const f32x4*)(gIn + col0 + bj * 128), g1 = *(const f32x4*)(gIn + col0 + bj * 128 + 4), b0 = *(const f32x4*)(bIn + col0 + bj * 128), b1 = *(const f32x4*)(bIn + col0 + bj * 128 + 4);
                              r0 = (r0 - mu) * rstd * g0 + b0; r1 = (r1 - mu) * rstd * g1 + b1; }
                    const f32x4 t0 = r0 * ALPHA + acc[ai][bj][m][0] * sacc, t1 = r1 * ALPHA + acc[ai][bj][m][1] * sacc;
                    u32x4 w; w.x = cvt_pk_bf16(t0[0], t0[1]); w.y = cvt_pk_bf16(t0[2], t0[3]); w.z = cvt_pk_bf16(t1[0], t1[1]); w.w = cvt_pk_bf16(t1[2], t1[3]);
                    *(u32x4*)(TB + off + bj * 128) = w;
                    const float q0 = __uint_as_float(w.x << 16), q1 = __uint_as_float(w.x & 0xffff0000u), q2 = __uint_as_float(w.y << 16), q3 = __uint_as_float(w.y & 0xffff0000u),
                                q4 = __uint_as_float(w.z << 16), q5 = __uint_as_float(w.z & 0xffff0000u), q6 = __uint_as_float(w.w << 16), q7 = __uint_as_float(w.w & 0xffff0000u);
                    ps += ((q0 + q1) + (q2 + q3)) + ((q4 + q5) + (q6 + q7));
                    pq += ((q0 * q0 + q1 * q1) + (q2 * q2 + q3 * q3)) + ((q4 * q4 + q5 * q5) + (q6 * q6 + q7 * q7));
                }
                ps += __shfl_xor(ps, 16); ps += __shfl_xor(ps, 32); pq += __shfl_xor(pq, 16); pq += __shfl_xor(pq, 32);
                if (fq == 0) { atomicAdd(stOut + 2 * (size_t)row, ps); atomicAdd(stOut + 2 * (size_t)row + 1, pq); }
                if (m & 1) asm volatile("" ::: "memory");
            }
    }
};
struct EpiBf16 {
    static constexpr bool PERM = true;
    bf16_t* O; int ldc;
    __device__ __forceinline__ void operator()(const f32x4 (&acc)[2][2][4][2], const Unit& u, int wr, int wc, int fr, int fq) const {
        const int row0 = u.pm * 256 + wr * 64 + fr, col0 = u.pn * 256 + wc * 32 + 8 * fq;
#pragma unroll
        for (int ai = 0; ai < 2; ++ai)
#pragma unroll
            for (int m = 0; m < 4; ++m)
#pragma unroll
                for (int bj = 0; bj < 2; ++bj) {
                    const f32x4 v0 = acc[ai][bj][m][0], v1 = acc[ai][bj][m][1];
                    u32x4 w; w.x = cvt_pk_bf16(v0[0], v0[1]); w.y = cvt_pk_bf16(v0[2], v0[3]); w.z = cvt_pk_bf16(v1[0], v1[1]); w.w = cvt_pk_bf16(v1[2], v1[3]);
                    *(u32x4*)(O + (size_t)(row0 + ai * 128 + m * 16) * ldc + col0 + bj * 128) = w;
                }
    }
};
struct EpiWin {
    static constexpr bool PERM = true;
    bf16_t* Z; const float* rope; const float* ST; const float* S; const float* C;
    __device__ __forceinline__ void operator()(const f32x4 (&acc)[2][2][4][2], const Unit& u, int wr, int wc, int fr, int fq) const {
        const int tile = u.pn;
        const int row0 = u.pm * 256 + wr * 64 + fr;
        f32x4 s4[2][2], c4[2][2];
#pragma unroll
        for (int bj = 0; bj < 2; ++bj)
#pragma unroll
            for (int n = 0; n < 2; ++n) { const int gc = tile * 256 + bj * 128 + wc * 32 + 8 * fq + 4 * n; s4[bj][n] = *(const f32x4*)(S + gc); c4[bj][n] = *(const f32x4*)(C + gc); }
#pragma unroll
        for (int ai = 0; ai < 2; ++ai)
#pragma unroll
            for (int m = 0; m < 4; ++m) {
                const int row = row0 + ai * 128 + m * 16;
                const int pos = (row >= MP) ? 4096 + ((row - MP) & 63) : (row & 8191);
                float mu, rstd; ln_stats(ST, row, mu, rstd);
#pragma unroll
                for (int bj = 0; bj < 2; ++bj) {
                    f32x4 v0 = (acc[ai][bj][m][0] - s4[bj][0] * mu) * rstd + c4[bj][0], v1 = (acc[ai][bj][m][1] - s4[bj][1] * mu) * rstd + c4[bj][1];
                    const int cin = bj * 128 + wc * 32 + 8 * fq;
                    if (tile < 2 || (tile == 2 && bj == 0)) {
                        f32x4 p0, p1;
#pragma unroll
                        for (int j = 0; j < 4; ++j) { p0[j] = __shfl_xor(v0[j], 16); p1[j] = __shfl_xor(v1[j], 16); }
                        if ((wc & 1) == 0 && fq < 2) {
                            const f32x4* rp = (const f32x4*)(rope + (size_t)pos * 16);
                            const f32x4 c0 = rp[0], c1 = rp[1], s0 = rp[2], s1 = rp[3];
                            const float sg = (fq == 0) ? -1.f : 1.f;
                            v0 = v0 * c0 + p0 * s0 * sg; v1 = v1 * c1 + p1 * s1 * sg;
                        }
                    }
                    u32x4 w; w.x = cvt_pk_bf16(v0[0], v0[1]); w.y = cvt_pk_bf16(v0[2], v0[3]); w.z = cvt_pk_bf16(v1[0], v1[1]); w.w = cvt_pk_bf16(v1[2], v1[3]);
                    *(u32x4*)(Z + (size_t)row * NIN + tile * 256 + cin) = w;
                }
                asm volatile("" ::: "memory");
            }
    }
};
struct EpiFinal {
    static constexpr bool PERM = true;
    float* Y; const bf16_t* TB; const bf16_t* PE; const float* ST; const float* S; const float* C; const float* g3; const float* b3;
    __device__ __forceinline__ void operator()(const f32x4 (&acc)[2][2][4][2], const Unit& u, int wr, int wc, int fr, int fq) const {
        const int row0 = u.pm * 256 + wr * 64 + fr, col0 = u.pn * 256 + wc * 32 + 8 * fq;
#pragma unroll
        for (int ai = 0; ai < 2; ++ai)
#pragma unroll
            for (int m = 0; m < 4; ++m) {
                const int row = row0 + ai * 128 + m * 16;
                const size_t off = (size_t)row * DM + col0;
                float mu, rstd; ln_stats(ST, row, mu, rstd);
#pragma unroll
                for (int bj = 0; bj < 2; ++bj) {
                    const u32x4 tw = *(const u32x4*)(TB + off + bj * 128), pw = *(const u32x4*)(PE + off + bj * 128);
                    const unsigned tws[4] = {tw.x, tw.y, tw.z, tw.w}, pws[4] = {pw.x, pw.y, pw.z, pw.w};
#pragma unroll
                    for (int n = 0; n < 2; ++n) {
                        const int cc = col0 + bj * 128 + 4 * n;
                        const f32x4 g4 = *(const f32x4*)(g3 + cc), b4 = *(const f32x4*)(b3 + cc), s4 = *(const f32x4*)(S + cc), c4 = *(const f32x4*)(C + cc);
                        f32x4 t, pe;
                        t[0] = __uint_as_float(tws[2 * n] << 16); t[1] = __uint_as_float(tws[2 * n] & 0xffff0000u); t[2] = __uint_as_float(tws[2 * n + 1] << 16); t[3] = __uint_as_float(tws[2 * n + 1] & 0xffff0000u);
                        pe[0] = __uint_as_float(pws[2 * n] << 16); pe[1] = __uint_as_float(pws[2 * n] & 0xffff0000u); pe[2] = __uint_as_float(pws[2 * n + 1] << 16); pe[3] = __uint_as_float(pws[2 * n + 1] & 0xffff0000u);
                        const f32x4 h = (t - mu) * rstd * g4 + b4;
                        const f32x4 a = (acc[ai][bj][m][n] - s4 * mu) * rstd + c4;
                        f32x4 y;
#pragma unroll
                        for (int j = 0; j < 4; ++j) y[j] = h[j] + fast_sigmoid(a[j]) * pe[j];
                        *(f32x4*)(Y + off + bj * 128 + 4 * n) = y;
                    }
                }
                if (m & 1) asm volatile("" ::: "memory");
            }
    }
};

template <class Inner, int S, int NN, int IDX> struct EpiSplit {
    static constexpr bool PERM = Inner::PERM;
    Inner inner; unsigned char* ws;
    __device__ __forceinline__ void operator()(f32x4 (&acc)[2][2][4][2], const Unit& u, int wr, int wc, int fr, int fq) const {
        const int tile = (u.pm - 256) * NN + u.pn, tid = threadIdx.x;
        unsigned char* wb = ws; asm volatile("" : "+s"(wb));
        float* buf = (float*)(wb + WS_ACCB) + (size_t)(IDX * 8 + tile) * 65536 + tid;
        unsigned* tickets = (unsigned*)(wb + WS_STATS + WS_TICK_OFF) + IDX * 8;
        volatile LAS unsigned* flag = (volatile LAS unsigned*)(unsigned)(131072 + 336);
        float* p = buf;
#pragma unroll
        for (int ai = 0; ai < 2; ++ai)
#pragma unroll
            for (int bj = 0; bj < 2; ++bj)
#pragma unroll
                for (int m = 0; m < 4; ++m)
#pragma unroll
                    for (int n = 0; n < 2; ++n)
#pragma unroll
                        for (int j = 0; j < 4; ++j) { atomicAdd(p, acc[ai][bj][m][n][j]); p += 512; asm volatile("" : "+v"(p)); }
        asm volatile("s_waitcnt vmcnt(0)" ::: "memory");
        __syncthreads();
        if (tid == 0) { __threadfence(); const unsigned old = atomicAdd(tickets + tile, 1u); *flag = (old == (unsigned)(S - 1)) ? 1u : 0u; }
        __syncthreads();
        if (*flag != 0u) {
            __builtin_amdgcn_fence(__ATOMIC_ACQUIRE, "agent");
            p = buf;
#pragma unroll
            for (int ai = 0; ai < 2; ++ai)
#pragma unroll
                for (int bj = 0; bj < 2; ++bj)
#pragma unroll
                    for (int m = 0; m < 4; ++m)
#pragma unroll
                        for (int n = 0; n < 2; ++n)
#pragma unroll
                            for (int j = 0; j < 4; ++j) { acc[ai][bj][m][n][j] = __hip_atomic_load(p, __ATOMIC_RELAXED, __HIP_MEMORY_SCOPE_AGENT); p += 512; asm volatile("" : "+v"(p)); }
            inner(acc, u, wr, wc, fr, fq);
        }
    }
};

struct Args { const float* in[32]; float* out; unsigned char* ws; };

__device__ __forceinline__ float wave_sum(float v) {
#pragma unroll
    for (int o = 1; o < 64; o <<= 1) v += __shfl_xor(v, o);
    return v;
}
__device__ __forceinline__ float bf2f(unsigned short h) { return __uint_as_float(((unsigned)h) << 16); }

__device__ __forceinline__ void cvt_f32_bf16(const float* src, bf16_t* dst, size_t ngroups, size_t gt, size_t gs) {
    size_t i = gt;
    for (; i + 7 * gs < ngroups; i += 8 * gs) {
        f32x4 v[8][2];
#pragma unroll
        for (int k = 0; k < 8; ++k) { const float* sp = src + (i + k * gs) * 8; v[k][0] = *(const f32x4*)sp; v[k][1] = *(const f32x4*)(sp + 4); }
#pragma unroll
        for (int k = 0; k < 8; ++k) { u32x4 w; w.x = cvt_pk_bf16(v[k][0][0], v[k][0][1]); w.y = cvt_pk_bf16(v[k][0][2], v[k][0][3]); w.z = cvt_pk_bf16(v[k][1][0], v[k][1][1]); w.w = cvt_pk_bf16(v[k][1][2], v[k][1][3]);
            *(u32x4*)(dst + (i + k * gs) * 8) = w; }
    }
    for (; i < ngroups; i += gs) {
        const float* sp = src + i * 8; const f32x4 v0 = *(const f32x4*)sp, v1 = *(const f32x4*)(sp + 4);
        u32x4 w; w.x = cvt_pk_bf16(v0[0], v0[1]); w.y = cvt_pk_bf16(v0[2], v0[3]); w.z = cvt_pk_bf16(v1[0], v1[1]); w.w = cvt_pk_bf16(v1[2], v1[3]);
        *(u32x4*)(dst + i * 8) = w;
    }
}

__device__ __forceinline__ void transpose_item(const float* W, int K, int N, bf16_t* WT, int k0, int n0, int drow0, LAS float* scr, int lane,
                                               const float* gk, const float* bk, float* S, float* C) {
    float cpart = 0.f;
#pragma unroll
    for (int i = 0; i < 32; ++i) { const int kk = 2 * i + (lane >> 5); float w = W[(size_t)(k0 + kk) * N + n0 + (lane & 31)];
        if (gk) { cpart += bk[k0 + kk] * w; w *= gk[k0 + kk]; }
        scr[kk * 33 + (lane & 31)] = w; }
    if (gk) { cpart += __shfl_xor(cpart, 32); if (lane < 32) atomicAdd(C + drow0 + lane, cpart); }
    asm volatile("s_waitcnt lgkmcnt(0)" ::: "memory");
    const int c = lane & 7;
#pragma unroll
    for (int j = 0; j < 4; ++j) { const int n = (lane >> 3) + 8 * j; const LAS float* sp = scr + (8 * c) * 33 + n;
        u32x4 o; o.x = cvt_pk_bf16(sp[0 * 33], sp[1 * 33]); o.y = cvt_pk_bf16(sp[2 * 33], sp[3 * 33]); o.z = cvt_pk_bf16(sp[4 * 33], sp[5 * 33]); o.w = cvt_pk_bf16(sp[6 * 33], sp[7 * 33]);
        *(u32x4*)(WT + (size_t)(drow0 + n) * K + k0 + 8 * c) = o;
        if (gk) {
            float sp8 = (__uint_as_float(o.x << 16) + __uint_as_float(o.x & 0xffff0000u)) + (__uint_as_float(o.y << 16) + __uint_as_float(o.y & 0xffff0000u))
                      + (__uint_as_float(o.z << 16) + __uint_as_float(o.z & 0xffff0000u)) + (__uint_as_float(o.w << 16) + __uint_as_float(o.w & 0xffff0000u));
            sp8 += __shfl_xor(sp8, 1); sp8 += __shfl_xor(sp8, 2); sp8 += __shfl_xor(sp8, 4);
            if (c == 0) atomicAdd(S + drow0 + n, sp8);
        } }
    asm volatile("s_waitcnt lgkmcnt(0)" ::: "memory");
}
__device__ __forceinline__ void transpose_matrix_item(const float* W, int K, int N, bf16_t* WT, int mode, int item, LAS float* scr, int lane,
                                                      const float* gk = nullptr, const float* bk = nullptr, float* S = nullptr, float* C = nullptr) {
    const int nblk = N / 32, kb = item / nblk, nb = item % nblk, n0 = 32 * nb;
    const int drow0 = (mode == 0) ? n0 : ((n0 >> 7) * 256 + (n0 & 127) + (mode == 2 ? 128 : 0));
    transpose_item(W, K, N, WT, 64 * kb, n0, drow0, scr, lane, gk, bk, S, C);
}

__device__ __forceinline__ void ln_row(float* trow, const float* g, const float* b, bf16_t* hrow, int lane) {
    f32x4* xr = (f32x4*)trow + lane;
    f32x4 v[4]; float s = 0.f;
#pragma unroll
    for (int j = 0; j < 4; ++j) { v[j] = xr[64 * j]; s += (v[j][0] + v[j][1]) + (v[j][2] + v[j][3]); }
    const float mean = wave_sum(s) * (1.f / DM); float s2 = 0.f;
#pragma unroll
    for (int j = 0; j < 4; ++j) { v[j] = v[j] - mean; s2 += (v[j][0] * v[j][0] + v[j][1] * v[j][1]) + (v[j][2] * v[j][2] + v[j][3] * v[j][3]); }
    const float rstd = 1.f / sqrtf(wave_sum(s2) * (1.f / DM) + LN_EPS);
    u32x2* o8 = (u32x2*)hrow + lane;
#pragma unroll
    for (int j = 0; j < 4; ++j) {
        const f32x4 gg = ((const f32x4*)g)[lane + 64 * j], bb = ((const f32x4*)b)[lane + 64 * j];
        const f32x4 y = v[j] * rstd * gg + bb;
        xr[64 * j] = y;
        u32x2 w; w.x = cvt_pk_bf16(y[0], y[1]); w.y = cvt_pk_bf16(y[2], y[3]); o8[64 * j] = w;
    }
}

constexpr int KP = 72  , VP = 196  ;
constexpr int ATT_K_OFF = 0, ATT_V_OFF = 192 * KP * 2;
__device__ __forceinline__ void attn_unit(LAS unsigned char* lds, const bf16_t* Z, bf16_t* MIX, const float* cache_k, const float* cache_v, const float* sinks, int item) {
    const int tid = threadIdx.x, lane = tid & 63, wave = __builtin_amdgcn_readfirstlane(tid >> 6), l16 = lane & 15, fq = lane >> 4;
    const bool samp = item >= 2048;
    int b, c, kvh;
    if (samp) { const int s = item - 2048; kvh = s & 1; b = s >> 1; c = 2; } else { kvh = item & 1; c = (item >> 1) & 127; b = item >> 8; }
    const int qtok0 = samp ? (MP + b * 64) : (b * 8192 + c * 64);
    const int k_lo = (!samp && c < 2) ? (2 - c) * 64 : 0;
    LAS bf16_t* KL = (LAS bf16_t*)(lds + ATT_K_OFF);
    LAS bf16_t* VL = (LAS bf16_t*)(lds + ATT_V_OFF);
    __syncthreads();
#pragma unroll
    for (int i = 0; i < 3; ++i) {
        const int p = tid + 512 * i, row = p >> 3, seg = p & 7;
        u32x4 kv = {0u, 0u, 0u, 0u}, vv = {0u, 0u, 0u, 0u};
        if (samp && row < 128) {
            const float* ks = cache_k + ((size_t)(b * 128 + row) * 128 + kvh * 64 + seg * 8);
            const float* vs = cache_v + ((size_t)(b * 128 + row) * 128 + kvh * 64 + seg * 8);
            const f32x4 k0 = *(const f32x4*)ks, k1 = *(const f32x4*)(ks + 4), v0 = *(const f32x4*)vs, v1 = *(const f32x4*)(vs + 4);
            kv.x = cvt_pk_bf16(k0[0], k0[1]); kv.y = cvt_pk_bf16(k0[2], k0[3]); kv.z = cvt_pk_bf16(k1[0], k1[1]); kv.w = cvt_pk_bf16(k1[2], k1[3]);
            vv.x = cvt_pk_bf16(v0[0], v0[1]); vv.y = cvt_pk_bf16(v0[2], v0[3]); vv.z = cvt_pk_bf16(v1[0], v1[1]); vv.w = cvt_pk_bf16(v1[2], v1[3]);
        } else if (row >= k_lo) {
            const int tok = samp ? (MP + b * 64 + (row - 128)) : (b * 8192 + (c - 2) * 64 + row);
            const bf16_t* zr = Z + (size_t)tok * NIN + kvh * 64 + seg * 8;
            kv = *(const u32x4*)(zr + 512); vv = *(const u32x4*)(zr + 640);
        }
        *(LAS u32x4*)(KL + row * KP + seg * 8) = kv;
        LAS bf16_t* vd = VL + (seg * 8) * VP + row;
        vd[0 * VP] = (bf16_t)(vv.x & 0xffff); vd[1 * VP] = (bf16_t)(vv.x >> 16); vd[2 * VP] = (bf16_t)(vv.y & 0xffff); vd[3 * VP] = (bf16_t)(vv.y >> 16);
        vd[4 * VP] = (bf16_t)(vv.z & 0xffff); vd[5 * VP] = (bf16_t)(vv.z >> 16); vd[6 * VP] = (bf16_t)(vv.w & 0xffff); vd[7 * VP] = (bf16_t)(vv.w >> 16);
    }
    __syncthreads();
    const int g = wave >> 1, qh = wave & 1, h = kvh * 4 + g;
    const float sink = sinks[h];
    bf16x8 Qf[2][2];
#pragma unroll
    for (int qt = 0; qt < 2; ++qt)
#pragma unroll
        for (int ks = 0; ks < 2; ++ks) Qf[qt][ks] = *(const bf16x8*)(Z + (size_t)(qtok0 + 32 * qh + 16 * qt + l16) * NIN + h * 64 + 32 * ks + 8 * fq);
    f32x4 S[12][2];
#pragma unroll
    for (int kt = 0; kt < 12; ++kt) {
        S[kt][0] = (f32x4){0.f, 0.f, 0.f, 0.f}; S[kt][1] = (f32x4){0.f, 0.f, 0.f, 0.f};
#pragma unroll
        for (int ks = 0; ks < 2; ++ks) {
            const bf16x8 Kf = *(const LAS bf16x8*)(KL + (16 * kt + l16) * KP + 32 * ks + 8 * fq);
            S[kt][0] = __builtin_amdgcn_mfma_f32_16x16x32_bf16(Kf, Qf[0][ks], S[kt][0], 0, 0, 0);
            S[kt][1] = __builtin_amdgcn_mfma_f32_16x16x32_bf16(Kf, Qf[1][ks], S[kt][1], 0, 0, 0);
        }
    }
    float inv[2];
#pragma unroll
    for (int qt = 0; qt < 2; ++qt) {
        float mx = sink;
#pragma unroll
        for (int kt = 0; kt < 12; ++kt) {
            const bool ok = (16 * kt >= k_lo);
#pragma unroll
            for (int r = 0; r < 4; ++r) { const float s = ok ? S[kt][qt][r] * 0.125f : -1e30f; S[kt][qt][r] = s; mx = fmaxf(mx, s); }
        }
        mx = fmaxf(mx, __shfl_xor(mx, 16)); mx = fmaxf(mx, __shfl_xor(mx, 32));
        float sum = 0.f;
#pragma unroll
        for (int kt = 0; kt < 12; ++kt)
#pragma unroll
            for (int r = 0; r < 4; ++r) { const float p = __expf(S[kt][qt][r] - mx); S[kt][qt][r] = p; sum += p; }
        sum += __shfl_xor(sum, 16); sum += __shfl_xor(sum, 32);
        sum += __expf(sink - mx);
        inv[qt] = 1.0f / sum;
    }
    f32x4 O[4][2];
#pragma unroll
    for (int dt = 0; dt < 4; ++dt) { O[dt][0] = (f32x4){0.f, 0.f, 0.f, 0.f}; O[dt][1] = (f32x4){0.f, 0.f, 0.f, 0.f}; }
#pragma unroll
    for (int kp = 0; kp < 6; ++kp) {
        bf16x8 Pf[2];
#pragma unroll
        for (int qt = 0; qt < 2; ++qt) {
            u32x4 w; const f32x4 a = S[2 * kp][qt], bq = S[2 * kp + 1][qt];
            w.x = cvt_pk_bf16(a[0], a[1]); w.y = cvt_pk_bf16(a[2], a[3]); w.z = cvt_pk_bf16(bq[0], bq[1]); w.w = cvt_pk_bf16(bq[2], bq[3]);
            Pf[qt] = __builtin_bit_cast(bf16x8, w);
        }
#pragma unroll
        for (int dt = 0; dt < 4; ++dt) {
            const LAS bf16_t* vp = VL + (16 * dt + l16) * VP + 32 * kp + 4 * fq;
            const u32x2 lo = *(const LAS u32x2*)vp, hi = *(const LAS u32x2*)(vp + 16);
            u32x4 w; w.x = lo.x; w.y = lo.y; w.z = hi.x; w.w = hi.y;
            const bf16x8 Vf = __builtin_bit_cast(bf16x8, w);
            O[dt][0] = __builtin_amdgcn_mfma_f32_16x16x32_bf16(Vf, Pf[0], O[dt][0], 0, 0, 0);
            O[dt][1] = __builtin_amdgcn_mfma_f32_16x16x32_bf16(Vf, Pf[1], O[dt][1], 0, 0, 0);
        }
    }
#pragma unroll
    for (int qt = 0; qt < 2; ++qt)
#pragma unroll
        for (int dt = 0; dt < 4; ++dt) {
            const f32x4 o = O[dt][qt] * inv[qt];
            u32x2 w; w.x = cvt_pk_bf16(o[0], o[1]); w.y = cvt_pk_bf16(o[2], o[3]);
            *(u32x2*)(MIX + (size_t)(qtok0 + 32 * qh + 16 * qt + l16) * DM + h * 64 + 16 * dt + 4 * fq) = w;
        }
}

template <int CTRL> __device__ __forceinline__ float dpp_shr(float idv, float v) {
    return __int_as_float(__builtin_amdgcn_update_dpp(__float_as_int(idv), __float_as_int(v), CTRL, 0xf, 0xf, false));
}
constexpr int XSP = 72;
constexpr int LRU_WAVE_BYTES = 10240;
struct LruP { const bf16_t* Z; bf16_t* MIX; const bf16_t* WaT; const bf16_t* WxT; const float *conv_w, *conv_b, *ba, *bx, *lam, *state_conv, *state_h; float *CP, *CH, *out; };
template <bool PASSC>
__device__ __forceinline__ void lru_unit(LAS unsigned char* lds, const LruP& P, int unit, int blk = -1) {
    const int tid = threadIdx.x, lane = tid & 63, wave = __builtin_amdgcn_readfirstlane(tid >> 6), l16 = lane & 15, fq = lane >> 4;
    const bool samp = unit >= 1024;
    const int b = samp ? unit - 1024 : unit >> 7, c = samp ? 0 : ((unit & 127) + 32 * ((unit >> 8) & 3)) & 127;
    const int tok0 = samp ? MP + b * 64 : b * 8192 + c * 64;
    const int nb = (blk >= 0) ? blk : wave;
    const int ch0 = nb * 64;
    LAS bf16_t* XS = (LAS bf16_t*)(lds + wave * LRU_WAVE_BYTES);
    LAS float* HS = (LAS float*)(lds + wave * LRU_WAVE_BYTES + 9728);
#pragma unroll
    for (int i = 0; i < 9; ++i) {
        const int p = lane + 64 * i;
        if (p < 536) {
            const int r = p >> 3, seg = p & 7, tr = r - 3;
            u32x4 v = {0u, 0u, 0u, 0u};
            if (tr >= 0 || (!samp && c > 0)) v = *(const u32x4*)(P.Z + (size_t)(tok0 + tr) * NIN + 768 + ch0 + seg * 8);
            else if (samp) {
                const float* s = P.state_conv + ((size_t)(b * 3 + r) * 512 + ch0 + seg * 8);
                const f32x4 a0 = *(const f32x4*)s, a1 = *(const f32x4*)(s + 4);
                v.x = cvt_pk_bf16(a0[0], a0[1]); v.y = cvt_pk_bf16(a0[2], a0[3]); v.z = cvt_pk_bf16(a1[0], a1[1]); v.w = cvt_pk_bf16(a1[2], a1[3]);
            }
            *(LAS u32x4*)(XS + r * XSP + seg * 8) = v;
        }
    }
    if (PASSC) {
        float hst = 0.f;
        if (samp) hst = P.state_h[b * 512 + ch0 + lane];
        else {
            const float* cp = P.CP + (size_t)(b * 128) * 512 + ch0 + lane; const float* chp = P.CH + (size_t)(b * 128) * 512 + ch0 + lane;
#pragma unroll 16
            for (int cc = 0; cc < c; ++cc) hst = cp[(size_t)cc * 512] * hst + chp[(size_t)cc * 512];
        }
        HS[lane] = hst;
    }
    bf16x8 Xf[4][2];
#pragma unroll
    for (int ks = 0; ks < 2; ++ks) {
        const int chl = 32 * ks + 8 * fq;
        float cw[4][8], cb[8];
#pragma unroll
        for (int j = 0; j < 4; ++j) { const f32x4 a0 = *(const f32x4*)(P.conv_w + j * 512 + ch0 + chl), a1 = *(const f32x4*)(P.conv_w + j * 512 + ch0 + chl + 4);
#pragma unroll
            for (int e = 0; e < 4; ++e) { cw[j][e] = a0[e]; cw[j][4 + e] = a1[e]; } }
        { const f32x4 a0 = *(const f32x4*)(P.conv_b + ch0 + chl), a1 = *(const f32x4*)(P.conv_b + ch0 + chl + 4);
#pragma unroll
            for (int e = 0; e < 4; ++e) { cb[e] = a0[e]; cb[4 + e] = a1[e]; } }
#pragma unroll
        for (int tt = 0; tt < 4; ++tt) {
            float xc[8];
#pragma unroll
            for (int e = 0; e < 8; ++e) xc[e] = cb[e];
#pragma unroll
            for (int j = 0; j < 4; ++j) {
                const u32x4 xv = *(const LAS u32x4*)(XS + (16 * tt + l16 + j) * XSP + chl);
                xc[0] += cw[j][0] * __uint_as_float(xv.x << 16); xc[1] += cw[j][1] * __uint_as_float(xv.x & 0xffff0000u);
                xc[2] += cw[j][2] * __uint_as_float(xv.y << 16); xc[3] += cw[j][3] * __uint_as_float(xv.y & 0xffff0000u);
                xc[4] += cw[j][4] * __uint_as_float(xv.z << 16); xc[5] += cw[j][5] * __uint_as_float(xv.z & 0xffff0000u);
                xc[6] += cw[j][6] * __uint_as_float(xv.w << 16); xc[7] += cw[j][7] * __uint_as_float(xv.w & 0xffff0000u);
            }
            u32x4 w; w.x = cvt_pk_bf16(xc[0], xc[1]); w.y = cvt_pk_bf16(xc[2], xc[3]); w.z = cvt_pk_bf16(xc[4], xc[5]); w.w = cvt_pk_bf16(xc[6], xc[7]);
            Xf[tt][ks] = __builtin_bit_cast(bf16x8, w);
        }
    }
#pragma unroll 1
    for (int ct = 0; ct < 4; ++ct) {
        const int chq = ch0 + 16 * ct + 4 * fq;
        f32x4 ga[4], gx[4], gi[4];
#pragma unroll
        for (int tt = 0; tt < 4; ++tt) { ga[tt] = (f32x4){0.f, 0.f, 0.f, 0.f}; gx[tt] = (f32x4){0.f, 0.f, 0.f, 0.f}; gi[tt] = (f32x4){0.f, 0.f, 0.f, 0.f}; }
#pragma unroll
        for (int ks = 0; ks < 2; ++ks) {
            const size_t wo = (size_t)nb * 4096 + (size_t)(16 * ct + l16) * 64 + 32 * ks + 8 * fq;
            const bf16x8 wa = *(const bf16x8*)(P.WaT + wo), wx = *(const bf16x8*)(P.WxT + wo);
            const int tgt = 16 * ct + l16 - 32 * ks - 8 * fq;
            const unsigned one = (tgt & 1) ? 0x3f800000u : 0x00003f80u;
            u32x4 iw; iw.x = (tgt >> 1) == 0 ? one : 0u; iw.y = (tgt >> 1) == 1 ? one : 0u; iw.z = (tgt >> 1) == 2 ? one : 0u; iw.w = (tgt >> 1) == 3 ? one : 0u;
            const bf16x8 wi = __builtin_bit_cast(bf16x8, iw);
#pragma unroll
            for (int tt = 0; tt < 4; ++tt) {
                ga[tt] = __builtin_amdgcn_mfma_f32_16x16x32_bf16(wa, Xf[tt][ks], ga[tt], 0, 0, 0);
                gx[tt] = __builtin_amdgcn_mfma_f32_16x16x32_bf16(wx, Xf[tt][ks], gx[tt], 0, 0, 0);
                gi[tt] = __builtin_amdgcn_mfma_f32_16x16x32_bf16(wi, Xf[tt][ks], gi[tt], 0, 0, 0);
            }
        }
        const f32x4 vba = *(const f32x4*)(P.ba + chq), vbx = *(const f32x4*)(P.bx + chq), vlam = *(const f32x4*)(P.lam + chq);
        const f32x4 c8 = vlam;
        f32x4 hprev = {0.f, 0.f, 0.f, 0.f}, ptot = {1.f, 1.f, 1.f, 1.f};
        if (PASSC) hprev = *(const LAS f32x4*)(HS + 16 * ct + 4 * fq);
#pragma unroll
        for (int tt = 0; tt < 4; ++tt) {
            const f32x4 xcv = gi[tt];
            f32x4 hv, pv;
#pragma unroll
            for (int r = 0; r < 4; ++r) {
                const float rr = fast_sigmoid(ga[tt][r] + vba[r]), ii = fast_sigmoid(gx[tt][r] + vbx[r]);
                const float la = c8[r] * rr;
                const float Pv = __expf(la);
                const float x2 = 2.0f * la;
                const float ser = -x2 * __builtin_fmaf(x2, 0.5f, 1.0f);
                const float om = (x2 > -0.0078125f) ? ser : __builtin_fmaf(-Pv, Pv, 1.0f);
                float Hv = __builtin_amdgcn_sqrtf(om) * (ii * xcv[r]);
                const float cin = (tt == 0) ? hprev[r] : dpp_shr<0x121>(0.f, hprev[r]);
                Hv = (l16 == 0) ? __builtin_fmaf(Pv, cin, Hv) : Hv;
                hv[r] = Hv; pv[r] = Pv;
            }
#define LRU_SCAN_STEP(N) \
            "v_fmac_f32_dpp %0, %0, %4 row_shr:" #N " row_mask:0xf bank_mask:0xf\n\t" "v_fmac_f32_dpp %1, %1, %5 row_shr:" #N " row_mask:0xf bank_mask:0xf\n\t" \
            "v_fmac_f32_dpp %2, %2, %6 row_shr:" #N " row_mask:0xf bank_mask:0xf\n\t" "v_fmac_f32_dpp %3, %3, %7 row_shr:" #N " row_mask:0xf bank_mask:0xf\n\t" \
            "v_mul_f32_dpp %4, %4, %4 row_shr:" #N " row_mask:0xf bank_mask:0xf\n\t" "v_mul_f32_dpp %5, %5, %5 row_shr:" #N " row_mask:0xf bank_mask:0xf\n\t" \
            "v_mul_f32_dpp %6, %6, %6 row_shr:" #N " row_mask:0xf bank_mask:0xf\n\t" "v_mul_f32_dpp %7, %7, %7 row_shr:" #N " row_mask:0xf bank_mask:0xf\n\t"
            {
                float h0 = hv[0], h1 = hv[1], h2 = hv[2], h3 = hv[3], p0 = pv[0], p1 = pv[1], p2 = pv[2], p3 = pv[3];
                asm("s_nop 1\n\t" LRU_SCAN_STEP(1) LRU_SCAN_STEP(2) LRU_SCAN_STEP(4) LRU_SCAN_STEP(8)
                    : "+v"(h0), "+v"(h1), "+v"(h2), "+v"(h3), "+v"(p0), "+v"(p1), "+v"(p2), "+v"(p3));
                hv[0] = h0; hv[1] = h1; hv[2] = h2; hv[3] = h3; pv[0] = p0; pv[1] = p1; pv[2] = p2; pv[3] = p3;
            }
#undef LRU_SCAN_STEP
            hprev = hv;
            if (!PASSC) ptot = ptot * pv;
            if (PASSC) {
                const size_t tok = (size_t)(tok0 + 16 * tt + l16);
                const u32x2 gw = *(const u32x2*)(P.Z + tok * NIN + 1280 + chq);
                f32x4 gb; gb[0] = __uint_as_float(gw.x << 16); gb[1] = __uint_as_float(gw.x & 0xffff0000u); gb[2] = __uint_as_float(gw.y << 16); gb[3] = __uint_as_float(gw.y & 0xffff0000u);
                f32x4 y;
#pragma unroll
                for (int r = 0; r < 4; ++r) { const float x = gb[r]; const float yy = 0.7978845608028654f * (x + 0.044715f * x * x * x); y[r] = hv[r] * x * fast_sigmoid(2.0f * yy); }
                u32x2 w; w.x = cvt_pk_bf16(y[0], y[1]); w.y = cvt_pk_bf16(y[2], y[3]);
                *(u32x2*)(P.MIX + tok * DM + 512 + chq) = w;
            }
        }
        if (l16 == 15) {
            if (PASSC) {
                if (samp) *(f32x4*)(P.out + O_NHS + b * 512 + chq) = hprev;
                else if (c == 127) *(f32x4*)(P.out + O_NHP + b * 512 + chq) = hprev;
            } else {
                *(f32x4*)(P.CP + (size_t)(b * 128 + c) * 512 + chq) = ptot;
                *(f32x4*)(P.CH + (size_t)(b * 128 + c) * 512 + chq) = hprev;
            }
        }
    }
}

#define XB_TMO      128
#define XB_XCNT(j)  (256  + 64 * (j))
#define XB_XSUB(j)  (1280 + 64 * (j))
#define XB_XGEN(j)  (2304 + 64 * (j))
#define XB_TOP      3328
#define XB_TOPGEN   3392
#define XCD_BAR_WORDS 3456
#define XB_SPIN_CAP (1u << 18)
__device__ __forceinline__ unsigned xb_ld(unsigned* p)              { return __hip_atomic_load(p, __ATOMIC_RELAXED, __HIP_MEMORY_SCOPE_AGENT); }
__device__ __forceinline__ unsigned xb_add(unsigned* p, unsigned v) { return __hip_atomic_fetch_add(p, v, __ATOMIC_RELAXED, __HIP_MEMORY_SCOPE_AGENT); }
__device__ __forceinline__ unsigned xb_xcc_id() { return (unsigned)__builtin_amdgcn_s_getreg((3 << 11) | 20) & 0xFu; }
#define XB_SPIN(cond, bar) do { unsigned _sp = 0; while (cond) { __builtin_amdgcn_s_sleep(1); \
    if ((++_sp & 255u) == 0u) { if (xb_ld(&(bar)[XB_TMO])) break; if (_sp > XB_SPIN_CAP) { atomicAdd(&(bar)[XB_TMO], 1u); break; } } } } while (0)
struct XcdBarrier { unsigned* bar; unsigned x; volatile LAS unsigned* st; };
__device__ __forceinline__ XcdBarrier xcd_barrier_post(unsigned* bar, volatile LAS unsigned* st) {
    XcdBarrier b; b.bar = bar; b.x = xb_xcc_id(); b.st = st;
    if (threadIdx.x == 0) (void)xb_add(&bar[XB_XCNT(b.x)], 1u);
    return b;
}
__device__ __forceinline__ void xcd_barrier_complete(unsigned* bar, unsigned x, unsigned& nloc, unsigned& nx) {
    const unsigned G = gridDim.x * gridDim.y * gridDim.z;
    unsigned sum, cnt, mine, sp = 0u;
    for (;;) {
        sum = 0u; cnt = 0u; mine = 0u;
#pragma unroll
        for (unsigned j = 0; j < 16; ++j) { const unsigned c = xb_ld(&bar[XB_XCNT(j)]); sum += c; cnt += (c > 0u) ? 1u : 0u; mine = (j == x) ? c : mine; }
        if (sum == G) break;
        __builtin_amdgcn_s_sleep(1);
        if ((++sp & 255u) == 0u) { if (xb_ld(&bar[XB_TMO])) break; if (sp > XB_SPIN_CAP) { atomicAdd(&bar[XB_TMO], 1u); break; } }
    }
    nloc = mine > 0u ? mine : 1u; nx = cnt > 0u ? cnt : 1u;
}
__device__ __forceinline__ void xcd_barrier(const XcdBarrier& b) {
    asm volatile("s_waitcnt vmcnt(0)" ::: "memory");
    __syncthreads();
    if (threadIdx.x == 0) {
        unsigned* bar = b.bar;
        __builtin_amdgcn_s_waitcnt(0);
        unsigned nloc = b.st[0], nx = b.st[1];
        if (nloc == 0u) { xcd_barrier_complete(bar, b.x, nloc, nx); b.st[0] = nloc; b.st[1] = nx; }
        const unsigned old = xb_add(&bar[XB_XSUB(b.x)], 1u);
        const unsigned gen = old / nloc;
        if (old + 1u == (gen + 1u) * nloc) {
            __builtin_amdgcn_fence(__ATOMIC_RELEASE, "agent");
            asm volatile("s_waitcnt vmcnt(0)" ::: "memory");
            const unsigned og = xb_add(&bar[XB_TOP], 1u);
            const unsigned tg = og / nx;
            if (og + 1u == (tg + 1u) * nx) xb_add(&bar[XB_TOPGEN], 1u);
            else XB_SPIN(xb_ld(&bar[XB_TOPGEN]) == tg, bar);
            __builtin_amdgcn_fence(__ATOMIC_ACQUIRE, "agent");
            xb_add(&bar[XB_XGEN(b.x)], 1u);
            asm volatile("s_waitcnt vmcnt(0)" ::: "memory");
        } else {
            XB_SPIN(xb_ld(&bar[XB_XGEN(b.x)]) == gen, bar);
            __builtin_amdgcn_fence(__ATOMIC_ACQUIRE, "agent");
            asm volatile("s_waitcnt vmcnt(0)" ::: "memory");
        }
    }
    __syncthreads();
}

#ifndef PHMASK
#define PHMASK 0xffff
#endif
constexpr int LDS_BYTES = 147456;
__global__ void __launch_bounds__(512, 2) fwd(Args a) {
    extern __shared__ __attribute__((aligned(16))) unsigned char lds_raw[];
    LAS unsigned char* lds = (LAS unsigned char*)lds_raw;
    cg::grid_group grid = cg::this_grid();
    const int tid = threadIdx.x, lane = tid & 63, wave = __builtin_amdgcn_readfirstlane(tid >> 6);
    const int G = gridDim.x, bx = blockIdx.x;
    const int gw = bx * 8 + wave, NGW = G * 8;
    unsigned char* ws = a.ws;
    float* out = a.out;
    bf16_t* W1GU = (bf16_t*)(ws + WS_W1GU); bf16_t* W1D = (bf16_t*)(ws + WS_W1D); bf16_t* WIN = (bf16_t*)(ws + WS_WIN); bf16_t* WOUT = (bf16_t*)(ws + WS_WOUT);
    bf16_t* W2GU = (bf16_t*)(ws + WS_W2GU); bf16_t* W2D = (bf16_t*)(ws + WS_W2D); bf16_t* WPG = (bf16_t*)(ws + WS_WPG); bf16_t* WPLE = (bf16_t*)(ws + WS_WPLE);
    bf16_t* WAT = (bf16_t*)(ws + WS_LRUW); bf16_t* WXT = WAT + 8 * 4096;
    float* C8T = (float*)(ws + WS_LRUW + 256 * 1024);
    float* ROPE = (float*)(ws + WS_ROPE); float* CP = (float*)(ws + WS_CP); float* CH = (float*)(ws + WS_CH);
    bf16_t* XB = (bf16_t*)(ws + WS_XB); bf16_t* MIX = XB; bf16_t* ACT = (bf16_t*)(ws + WS_ACT); bf16_t* PE = MIX;
    bf16_t* H1 = (bf16_t*)(ws + WS_H1); bf16_t* H3 = H1; bf16_t* Z = (bf16_t*)(ws + WS_Z); bf16_t* H2 = Z; bf16_t* PB = (bf16_t*)(ws + WS_PB);
    float* ST1 = (float*)(ws + WS_STATS); float* ST2 = ST1 + 2 * MT; float* ST3 = ST2 + 2 * MT;
    float* SC_IN_S = ST3 + 2 * MT; float* SC_IN_C = SC_IN_S + NIN; float* SC_GU_S = SC_IN_C + NIN; float* SC_GU_C = SC_GU_S + 2 * FF; float* SC_PG_S = SC_GU_C + 2 * FF; float* SC_PG_C = SC_PG_S + DM;
    bf16_t* TB1 = H1; bf16_t* TB2 = H2; bf16_t* TB3 = H3;
    float* T1 = out;
    volatile LAS unsigned* xst = (volatile LAS unsigned*)(lds + 131072 + 320);
    if (tid < 2) xst[tid] = 0u;
    __syncthreads();
    const XcdBarrier xbar = xcd_barrier_post((unsigned*)(ws + WS_STATS + WS_BAR_OFF), xst);
#define GRID_BAR() xcd_barrier(xbar)
    float* ACCB = (float*)(ws + WS_ACCB);
    {
        LAS float* scr = (LAS float*)(lds + wave * 16384);
        constexpr int I_GU = 16 * 88, I_D = 44 * 32, I_IN = 16 * 56, I_SQ = 16 * 32, I_PLE = 4 * 32, I_LRU = 2;
        constexpr int NITEMS = 4 * I_GU + 2 * I_D + I_IN + 2 * I_SQ + I_PLE + 16 * I_LRU;
        for (int it = gw; it < NITEMS; it += NGW) {
            int r = it;
            if (r < I_GU) { transpose_matrix_item(a.in[8], DM, FF, W1GU, 1, r, scr, lane); continue; } r -= I_GU;
            if (r < I_GU) { transpose_matrix_item(a.in[9], DM, FF, W1GU, 2, r, scr, lane); continue; } r -= I_GU;
            if (r < I_GU) { transpose_matrix_item(a.in[25], DM, FF, W2GU, 1, r, scr, lane, a.in[23], a.in[24], SC_GU_S, SC_GU_C); continue; } r -= I_GU;
            if (r < I_GU) { transpose_matrix_item(a.in[26], DM, FF, W2GU, 2, r, scr, lane, a.in[23], a.in[24], SC_GU_S, SC_GU_C); continue; } r -= I_GU;
            if (r < I_D) { transpose_matrix_item(a.in[10], FF, DM, W1D, 0, r, scr, lane); continue; } r -= I_D;
            if (r < I_D) { transpose_matrix_item(a.in[27], FF, DM, W2D, 0, r, scr, lane); continue; } r -= I_D;
            if (r < I_IN) { transpose_matrix_item(a.in[13], DM, NIN, WIN, 0, r, scr, lane, a.in[11], a.in[12], SC_IN_S, SC_IN_C); continue; } r -= I_IN;
            if (r < I_SQ) { transpose_matrix_item(a.in[22], DM, DM, WOUT, 0, r, scr, lane); continue; } r -= I_SQ;
            if (r < I_SQ) { transpose_matrix_item(a.in[31], DM, DM, WPG, 0, r, scr, lane, a.in[28], a.in[29], SC_PG_S, SC_PG_C); continue; } r -= I_SQ;
            if (r < I_PLE) { transpose_matrix_item(a.in[30], PLE, DM, WPLE, 0, r, scr, lane); continue; } r -= I_PLE;
            { const int blk = (r >> 1) & 7, which = r >> 4, sub = r & 1;
              transpose_matrix_item(a.in[which ? 19 : 17] + blk * 4096, 64, 64, (which ? WXT : WAT) + blk * 4096, 0, sub, scr, lane); }
        }
        const size_t gt = (size_t)bx * 512 + tid, gs = (size_t)G * 512;
        for (size_t i = gt; i < 512; i += gs) C8T[i] = -8.0f * log1pf(expf(-a.in[21][i]));
        for (size_t i = gt; i < (size_t)4 * 8 * 65536 / 4; i += gs) ((f32x4*)ACCB)[i] = (f32x4){0.f, 0.f, 0.f, 0.f};
        for (size_t i = gt; i < 8192 * 8; i += gs) {
            const int pos = (int)(i >> 3), j = (int)(i & 7);
            const float inv = powf(500000.0f, -(float)j * 0.125f);
            const float ang = (float)pos * inv;
            ROPE[pos * 16 + j] = cosf(ang); ROPE[pos * 16 + 8 + j] = sinf(ang);
        }
        cvt_f32_bf16(a.in[0], XB, (size_t)MP * DM / 8, gt, gs);
        cvt_f32_bf16(a.in[1], XB + (size_t)MP * DM, (size_t)MS * DM / 8, gt, gs);
        cvt_f32_bf16(a.in[2], PB, (size_t)MP * PLE / 8, gt, gs);
        cvt_f32_bf16(a.in[3], PB + (size_t)MP * PLE, (size_t)MS * PLE / 8, gt, gs);
        for (size_t i = gt; i < 8 * 64 * 128; i += gs) {
            const int b = (int)(i >> 13), rem = (int)(i & 8191);
            out[O_NKS + (size_t)b * 16384 + rem] = a.in[4][(size_t)b * 16384 + 8192 + rem];
            out[O_NVS + (size_t)b * 16384 + rem] = a.in[5][(size_t)b * 16384 + 8192 + rem];
        }
    }
    if (gridDim.y == 0x7fffu) grid.sync();
    GRID_BAR();
    { pg8::Gemm g{XB, W1GU, MT, 2 * FF, DM, DM}; pg8::StaticOrder S; S.init(MT, 2 * FF, G, bx); EpiSwiglu<false> E{ACT, nullptr, nullptr, nullptr};
      pg8::gemm_phase<EpiSwiglu<false>, pg8::StaticOrder, true, true>(lds, g, S, E); }
    GRID_BAR();
    { pg8::Gemm g{ACT, W1D, MT, DM, FF, FF}; pg8::StaticOrder S; S.init(MP, DM, G, bx); EpiResid<false, true> E{XB, TB1, nullptr, nullptr, nullptr, ST1};
      pg8::Gemm gs{ACT, W1D, MT, DM, FF, FF / 11}; pg8::SplitOrder SS; SS.init(DM, 11, G, bx); EpiSplit<EpiResid<false, true>, 11, 4, 0> ES{{XB, TB1, nullptr, nullptr, nullptr, ST1}, ws};
      pg8::gemm_phase<EpiSplit<EpiResid<false, true>, 11, 4, 0>, pg8::SplitOrder, true, true>(lds, gs, SS, ES);
      pg8::gemm_phase<EpiResid<false, true>, pg8::StaticOrder, true, true>(lds, g, S, E); }
    GRID_BAR();
    { pg8::Gemm g{TB1, WIN, MT, NIN, DM, DM}; pg8::StaticOrder S; S.init(MT, NIN, G, bx); EpiWin E{Z, ROPE, ST1, SC_IN_S, SC_IN_C};
      pg8::gemm_phase<EpiWin, pg8::StaticOrder, true, true>(lds, g, S, E); }
    GRID_BAR();
    LruP LP{Z, MIX, WAT, WXT, a.in[15], a.in[16], a.in[18], a.in[20], C8T, a.in[6], a.in[7], CP, CH, out};
#ifdef PROBE_REP56
    for (int rep56 = 0; rep56 < PROBE_REP56; ++rep56) {
#endif
    {
        const size_t gt = (size_t)bx * 512 + tid, gs = (size_t)G * 512;
        for (size_t i = gt; i < 2 * 8 * 128 * 256; i += gs) {
            const int col = (int)(i & 255), j = (int)((i >> 8) & 127), b = (int)((i >> 15) & 7), set = (int)(i >> 18);
            const int row = set ? (j >= 64 ? MP + b * 64 + (j - 64) : -1) : (b * 8192 + 8064 + j);
            if (row >= 0) {
                const float v = bf2f(Z[(size_t)row * NIN + 512 + col]);
                const size_t o = (col < 128) ? (set ? O_NKS : O_NKP) : (set ? O_NVS : O_NVP);
                out[o + (size_t)(b * 128 + j) * 128 + (col & 127)] = v;
            }
        }
        for (size_t i = gt; i < 2 * 8 * 3 * 512; i += gs) {
            const int ch = (int)(i & 511), r = (int)(i >> 9), j = r % 3, b = (r / 3) & 7, set = r / 24;
            const int row = set ? (MP + b * 64 + 61 + j) : (b * 8192 + 8189 + j);
            out[(set ? O_NCS : O_NCP) + (size_t)(b * 3 + j) * 512 + ch] = bf2f(Z[(size_t)row * NIN + 768 + ch]);
        }
    }
#ifndef PROBE_ATT
#define PROBE_ATT 1
#endif
#ifndef PROBE_LRUA
#define PROBE_LRUA 1
#endif
#ifndef PROBE_P6
#define PROBE_P6 1
#endif
    for (int rp = 0; rp < PROBE_ATT; ++rp)
    for (int it = bx; it < 2064; it += G) attn_unit(lds, Z, MIX, a.in[4], a.in[5], a.in[14], it);
    __syncthreads();
    for (int rp = 0; rp < PROBE_LRUA; ++rp)
    for (int it = bx; it < 1024; it += G) lru_unit<false>(lds, LP, it);
    if (G >= 80) { const int k = bx - (G - 64); if (k >= 0 && wave == 0) lru_unit<true>(lds, LP, 1024 + (k >> 3), k & 7); }
    else for (int it = bx; it < 8; it += G) lru_unit<true>(lds, LP, 1024 + it);
    GRID_BAR();
    for (int rp = 0; rp < PROBE_P6; ++rp)
    for (int it = bx; it < 1024; it += G) lru_unit<true>(lds, LP, it);
    GRID_BAR();
#ifdef PROBE_REP56
    }
#endif
    { pg8::Gemm g{MIX, WOUT, MT, DM, DM, DM}; pg8::StaticOrder S; S.init(MP, DM, G, bx); EpiResid<true, false> E{TB1, TB2, ST1, a.in[11], a.in[12], ST2};
      pg8::Gemm gs{MIX, WOUT, MT, DM, DM, DM / 4}; pg8::SplitOrder SS; SS.init(DM, 4, G, bx); EpiSplit<EpiResid<true, false>, 4, 4, 1> ES{{TB1, TB2, ST1, a.in[11], a.in[12], ST2}, ws};
      pg8::gemm_phase<EpiSplit<EpiResid<true, false>, 4, 4, 1>, pg8::SplitOrder, true, true>(lds, gs, SS, ES);
      pg8::gemm_phase<EpiResid<true, false>, pg8::StaticOrder, true, true>(lds, g, S, E); }
    GRID_BAR();
    { pg8::Gemm g{TB2, W2GU, MT, 2 * FF, DM, DM}; pg8::StaticOrder S; S.init(MT, 2 * FF, G, bx); EpiSwiglu<true> E{ACT, ST2, SC_GU_S, SC_GU_C};
      pg8::gemm_phase<EpiSwiglu<true>, pg8::StaticOrder, true, true>(lds, g, S, E); }
    { pg8::Gemm g{PB, WPLE, MT, DM, PLE, PLE}; pg8::StaticOrder S; S.init(MT, DM, G, bx); EpiBf16 E{PE, DM};
      pg8::gemm_phase<EpiBf16, pg8::StaticOrder, true, true>(lds, g, S, E); }
    GRID_BAR();
    { pg8::Gemm g{ACT, W2D, MT, DM, FF, FF}; pg8::StaticOrder S; S.init(MP, DM, G, bx); EpiResid<true, true> E{TB2, TB3, ST2, a.in[23], a.in[24], ST3};
      pg8::Gemm gs{ACT, W2D, MT, DM, FF, FF / 11}; pg8::SplitOrder SS; SS.init(DM, 11, G, bx); EpiSplit<EpiResid<true, true>, 11, 4, 2> ES{{TB2, TB3, ST2, a.in[23], a.in[24], ST3}, ws};
      pg8::gemm_phase<EpiSplit<EpiResid<true, true>, 11, 4, 2>, pg8::SplitOrder, true, true>(lds, gs, SS, ES);
      pg8::gemm_phase<EpiResid<true, true>, pg8::StaticOrder, true, true>(lds, g, S, E); }
    GRID_BAR();
    { pg8::Gemm g{TB3, WPG, MT, DM, DM, DM}; pg8::StaticOrder S; S.init(MP, DM, G, bx); EpiFinal E{T1, TB3, PE, ST3, SC_PG_S, SC_PG_C, a.in[28], a.in[29]};
      pg8::Gemm gs{TB3, WPG, MT, DM, DM, DM / 4}; pg8::SplitOrder SS; SS.init(DM, 4, G, bx); EpiSplit<EpiFinal, 4, 4, 3> ES{{T1, TB3, PE, ST3, SC_PG_S, SC_PG_C, a.in[28], a.in[29]}, ws};
      pg8::gemm_phase<EpiSplit<EpiFinal, 4, 4, 3>, pg8::SplitOrder, true, true>(lds, gs, SS, ES);
      pg8::gemm_phase<EpiFinal, pg8::StaticOrder, true, true>(lds, g, S, E); }
}

extern "C" void kernel_launch(void* const* d_in, const int* in_sizes, int n_in, void* d_out, int out_size, void* d_ws, size_t ws_size, hipStream_t stream) {
    static int grid = 0;
    if (grid == 0) {
        if (n_in != 32 || ws_size < WS_END) { fprintf(stderr, "kernel_launch: unexpected n_in %d / ws %zu\n", n_in, ws_size); grid = -1; return; }
        int dev = 0, cus = 0, per_cu = 0;
        (void)hipGetDevice(&dev);
        (void)hipDeviceGetAttribute(&cus, hipDeviceAttributeMultiprocessorCount, dev);
        (void)hipFuncSetAttribute((const void*)fwd, hipFuncAttributeMaxDynamicSharedMemorySize, LDS_BYTES);
        (void)hipOccupancyMaxActiveBlocksPerMultiprocessor(&per_cu, (const void*)fwd, 512, LDS_BYTES);
        if (per_cu < 1) per_cu = 1;
        grid = cus * per_cu;
    }
    if (grid < 0) return;
    if (hipMemsetAsync((char*)d_ws + WS_STATS, 0, STATS_ZERO_BYTES, stream) != hipSuccess) { fprintf(stderr, "kernel_launch: memset failed\n"); return; }
    Args a{};
    for (int i = 0; i < 32; ++i) a.in[i] = (const float*)d_in[i];
    a.out = (float*)d_out; a.ws = (unsigned char*)d_ws;
    void* args[] = {&a};
    hipError_t e = hipLaunchCooperativeKernel((const void*)fwd, dim3(grid), dim3(512), args, LDS_BYTES, stream);
    if (e != hipSuccess) fprintf(stderr, "cooperative launch failed: %s (grid %d)\n", hipGetErrorString(e), grid);
}
```

```cpp
#include <hip/hip_runtime.h>
#include <hip/hip_cooperative_groups.h>
#include <cstdio>
#include <cstdint>
namespace cg = cooperative_groups;

#define LAS __attribute__((address_space(3)))
typedef unsigned short bf16_t;
typedef short bf16x8 __attribute__((ext_vector_type(8)));
typedef float f32x4 __attribute__((ext_vector_type(4)));
typedef float f32x2 __attribute__((ext_vector_type(2)));
typedef unsigned u32x4 __attribute__((ext_vector_type(4)));
typedef unsigned u32x2 __attribute__((ext_vector_type(2)));

constexpr int MP = 65536, MS = 512, MT = MP + MS;
constexpr int DM = 1024, FF = 2816, NIN = 1792, PLE = 256;
constexpr float ALPHA = 1.189207115002721f;
constexpr float LN_EPS = 1e-5f;
constexpr size_t O_Y = 0, O_NKP = 67633152, O_NVP = 67764224, O_NCP = 67895296, O_NHP = 67907584,
                 O_NKS = 67911680, O_NVS = 68042752, O_NCS = 68173824, O_NHS = 68186112;
constexpr size_t MiB = 1u << 20;
constexpr size_t WS_W1GU = 0, WS_W1D = 12 * MiB, WS_WIN = 18 * MiB, WS_WOUT = 22 * MiB, WS_W2GU = 24 * MiB, WS_W2D = 36 * MiB,
                 WS_WPG = 42 * MiB, WS_WPLE = 44 * MiB, WS_LRUW = 45 * MiB, WS_ROPE = 46 * MiB, WS_CP = 47 * MiB, WS_CH = 49 * MiB,
                 WS_STATS = 52 * MiB  , STATS_ZERO_BYTES = 2 * MiB, WS_TICK_OFF = 1700 * 1024, WS_ACCB = 56 * MiB  , WS_BAR_OFF = 1792 * 1024  ,
                 WS_XB = 64 * MiB  , WS_ACT = 194 * MiB  , WS_H1 = 550 * MiB  ,
                 WS_Z = 680 * MiB  , WS_PB = 906 * MiB, WS_END = 940 * MiB;

namespace pg8 {
constexpr int BM = 256, BK = 64, HALF = 128, HTB = HALF * BK * 2, STAGE_BYTES = 8 * HTB, NXCD = 8, WGM = 8;
__host__ __device__ __forceinline__ int lds_byte(int r, int c) { const int st = (r >> 4) * 2 + (c >> 5), rr = r & 15, cc = c & 31, ob = rr * 64 + cc * 2; return st * 1024 + (ob ^ (((ob >> 9) & 1) << 5)); }
__host__ __device__ __forceinline__ void stage_rc(int b, int& R, int& C) { const int st = b / 1024, sb = b % 1024, swz = sb ^ (((sb >> 9) & 1) << 5); R = (st >> 1) * 16 + swz / 64; C = (st & 1) * 32 + (swz % 64) / 2; }
__host__ __device__ __forceinline__ int perm32(int rho) { const int n = rho >> 4, i = rho & 15; return 8 * (i >> 2) + 4 * n + (i & 3); }
struct Unit { int pm, pn, ks; };
struct Gemm { const bf16_t* A; const bf16_t* Bt; int M, N, K, Ks; };
struct StaticOrder {
    int nM, nN, nwg, G, c;
    __host__ __device__ void init(int M, int N, int G_, int c_) { nM = M / BM; nN = N / BM; nwg = nM * nN; G = G_; c = c_; }
    __host__ __device__ bool next(int i, Unit& u) const {
        const long L = (long)i * G + c; if (L >= nwg) return false;
        int wgid = (int)L; { const int q = nwg / NXCD, r = nwg % NXCD, xcd = wgid % NXCD, off = wgid / NXCD; wgid = (xcd < r ? xcd * (q + 1) : r * (q + 1) + (xcd - r) * q) + off; }
        const int nig = WGM * nN, gid = wgid / nig, fm = gid * WGM, gsz = (nM - fm) < WGM ? (nM - fm) : WGM;
        u.pm = fm + ((wgid % nig) % gsz); u.pn = (wgid % nig) / gsz; u.ks = 0; return true;
    }
    __device__ __forceinline__ void a_ready(const Unit&) const {}
    __device__ __forceinline__ void done(const Unit&) const {}
};
struct SplitOrder {
    int nN, S, nu, G, c;
    __host__ __device__ void init(int N, int S_, int G_, int c_) { nN = N / BM; S = S_; nu = 2 * nN * S; G = G_; c = c_; }
    __host__ __device__ bool next(int i, Unit& u) const {
        const int L = i * G + c; if (L >= nu) return false;
        const int t = L / S; u.ks = L % S; u.pn = t % nN; u.pm = 256 + t / nN; return true;
    }
    __device__ __forceinline__ void a_ready(const Unit&) const {}
    __device__ __forceinline__ void done(const Unit&) const {}
};
__device__ __forceinline__ unsigned cvt_pk_bf16(float lo, float hi) { unsigned r; asm volatile("v_cvt_pk_bf16_f32 %0, %1, %2" : "=v"(r) : "v"(lo), "v"(hi)); return r; }

template <class Epi, class Sched, bool ALIGN_EPI = false, bool SP2 = false>
__device__ __forceinline__ void gemm_phase(LAS unsigned char* lds, const Gemm g, const Sched& S, const Epi& E) {
    int tid_op = threadIdx.x; asm volatile("" : "+v"(tid_op));
    const int tid = tid_op, wid = __builtin_amdgcn_readfirstlane(tid >> 6), lane = tid & 63, wr = wid >> 2, wc = wid & 3, fr = lane & 15, fq = lane >> 4;
    int Kop = g.K; asm volatile("" : "+s"(Kop));
    int Ksop = g.Ks; asm volatile("" : "+s"(Ksop));
    const int K = Kop, nt = Ksop / BK;
    const size_t sstep = (size_t)Ksop * 2;
    unsigned voffA[2], voffB[2];
#pragma unroll
    for (int i = 0; i < 2; ++i) { int R, C; stage_rc(tid * 16 + i * 8192, R, C); const int Rb = Epi::PERM ? ((R & ~31) + perm32(R & 31)) : R;
        voffA[i] = (unsigned)(R * K + C) * 2u; voffB[i] = (unsigned)(Rb * K + C) * 2u; }
    const size_t kstep = (size_t)(BK * 2);
    const size_t hstep = (size_t)HALF * K * 2;
    const size_t tstep = 2 * hstep;
    const unsigned ldsw = (unsigned)wid * 1024u;
    const int aoff = lds_byte(wr * 64 + fr, fq * 8), boff = lds_byte(wc * 32 + fr, fq * 8);
#define PG8_SA(b, h) (((b) * 2 + (h)) * HTB)
#define PG8_SB(b, h) ((4 + (b) * 2 + (h)) * HTB)
#define PG8_STAGE(bufoff, gbase, voff) do { _Pragma("unroll") for (int _i = 0; _i < 2; ++_i) \
        __builtin_amdgcn_global_load_lds((const unsigned*)((const char*)(gbase) + (voff)[_i]), (LAS unsigned*)(lds + (bufoff) + ldsw + _i * 8192), 16, 0, 0); } while (0)
#define PG8_LDA(dst, b, h) do { _Pragma("unroll") for (int m = 0; m < 4; ++m) _Pragma("unroll") for (int k = 0; k < 2; ++k) dst[m][k] = *(const LAS bf16x8*)(lds + PG8_SA(b, h) + aoff + m * 2048 + k * 1024); } while (0)
#define PG8_LDB(dst, b, h) do { _Pragma("unroll") for (int n = 0; n < 2; ++n) _Pragma("unroll") for (int k = 0; k < 2; ++k) dst[n][k] = *(const LAS bf16x8*)(lds + PG8_SB(b, h) + boff + n * 2048 + k * 1024); } while (0)
#define PG8_MMA(ai, bj, At, Bt) do { __builtin_amdgcn_s_setprio(1); _Pragma("unroll") for (int m = 0; m < 4; ++m) _Pragma("unroll") for (int n = 0; n < 2; ++n) _Pragma("unroll") for (int k = 0; k < 2; ++k) \
        acc[ai][bj][m][n] = __builtin_amdgcn_mfma_f32_16x16x32_bf16(Bt[n][k], At[m][k], acc[ai][bj][m][n], 0, 0, 0); __builtin_amdgcn_s_setprio(0); } while (0)
#define PG8_WAIT_V(n) asm volatile("s_waitcnt vmcnt(" #n ")" ::: "memory")
#define PG8_WAIT_L(n) asm volatile("s_waitcnt lgkmcnt(" #n ")" ::: "memory")
#define PG8_BAR __builtin_amdgcn_s_barrier()
#define PG8_SCHED __builtin_amdgcn_sched_barrier(0)
    Unit cur, nxt; int ui = 0;
    if (!S.next(0, cur)) return;
    f32x4 acc[2][2][4][2];
#pragma unroll
    for (int a = 0; a < 2; ++a)
#pragma unroll
        for (int b = 0; b < 2; ++b)
#pragma unroll
            for (int m = 0; m < 4; ++m)
#pragma unroll
                for (int n = 0; n < 2; ++n) acc[a][b][m][n] = (f32x4){0.f, 0.f, 0.f, 0.f};
    bf16x8 At[4][2], B0[2][2], B1[2][2];
    const char* cA = (const char*)g.A + (size_t)cur.pm * tstep + (size_t)cur.ks * sstep; const char* cB = (const char*)g.Bt + (size_t)cur.pn * tstep + (size_t)cur.ks * sstep;
    S.a_ready(cur);
    if constexpr (SP2) {
        PG8_STAGE(PG8_SB(0, 0), cB, voffB); PG8_STAGE(PG8_SB(0, 1), cB + hstep, voffB); PG8_STAGE(PG8_SA(0, 0), cA, voffA); PG8_STAGE(PG8_SA(0, 1), cA + hstep, voffA);
        if (wr == 1) PG8_BAR;
        PG8_WAIT_V(2); PG8_BAR;
        PG8_STAGE(PG8_SB(1, 0), cB + kstep, voffB); PG8_STAGE(PG8_SA(1, 0), cA + kstep, voffA); PG8_STAGE(PG8_SB(1, 1), cB + hstep + kstep, voffB);
        PG8_WAIT_V(6); PG8_BAR;
    } else {
        PG8_STAGE(PG8_SB(0, 0), cB, voffB); PG8_STAGE(PG8_SA(0, 0), cA, voffA); PG8_STAGE(PG8_SB(0, 1), cB + hstep, voffB); PG8_STAGE(PG8_SA(0, 1), cA + hstep, voffA);
        if (wr == 1) PG8_BAR;
        PG8_WAIT_V(4); PG8_BAR;
        PG8_STAGE(PG8_SB(1, 0), cB + kstep, voffB); PG8_STAGE(PG8_SA(1, 0), cA + kstep, voffA); PG8_STAGE(PG8_SB(1, 1), cB + hstep + kstep, voffB);
        PG8_WAIT_V(6); PG8_BAR;
    }
    for (;;) {
        const bool has_next = S.next(ui + 1, nxt);
        const char* nA = has_next ? (const char*)g.A + (size_t)nxt.pm * tstep + (size_t)nxt.ks * sstep : cA; const char* nB = has_next ? (const char*)g.Bt + (size_t)nxt.pn * tstep + (size_t)nxt.ks * sstep : cB;
        for (int t = 0; t < nt; t += 2) {
            const bool last = (t == nt - 2);
            const char* a1 = cA + (size_t)(t + 1) * kstep;
            const char* a2 = last ? nA : cA + (size_t)(t + 2) * kstep; const char* b2 = last ? nB : cB + (size_t)(t + 2) * kstep;
            const char* a3 = a2 + kstep; const char* b3 = b2 + kstep;
            if (last && has_next) S.a_ready(nxt);
            if constexpr (SP2) {
            PG8_LDB(B0, 0, 0); PG8_LDB(B1, 0, 1); PG8_SCHED; PG8_LDA(At, 0, 0); PG8_STAGE(PG8_SA(1, 1), a1 + hstep, voffA);
            PG8_WAIT_V(8); PG8_WAIT_L(0); PG8_BAR; PG8_MMA(0, 0, At, B0); PG8_MMA(0, 1, At, B1); PG8_BAR; PG8_SCHED;
            PG8_LDA(At, 0, 1); PG8_STAGE(PG8_SB(0, 0), b2, voffB); PG8_STAGE(PG8_SB(0, 1), b2 + hstep, voffB); PG8_STAGE(PG8_SA(0, 0), a2, voffA);
            PG8_WAIT_V(8); PG8_WAIT_L(0); PG8_BAR; PG8_MMA(1, 0, At, B0); PG8_MMA(1, 1, At, B1); PG8_BAR; PG8_SCHED;
            PG8_LDB(B0, 1, 0); PG8_LDB(B1, 1, 1); PG8_SCHED; PG8_LDA(At, 1, 0); PG8_STAGE(PG8_SA(0, 1), a2 + hstep, voffA);
            PG8_WAIT_V(8); PG8_WAIT_L(0); PG8_BAR; PG8_MMA(0, 0, At, B0); PG8_MMA(0, 1, At, B1); PG8_BAR; PG8_SCHED;
            PG8_LDA(At, 1, 1); PG8_STAGE(PG8_SB(1, 0), b3, voffB); PG8_STAGE(PG8_SB(1, 1), b3 + hstep, voffB); PG8_STAGE(PG8_SA(1, 0), a3, voffA);
            PG8_WAIT_V(8); PG8_WAIT_L(0); PG8_BAR; PG8_MMA(1, 0, At, B0); PG8_MMA(1, 1, At, B1); PG8_BAR; PG8_SCHED;
            } else {
            PG8_LDB(B0, 0, 0); PG8_SCHED; PG8_LDA(At, 0, 0); PG8_STAGE(PG8_SA(1, 1), a1 + hstep, voffA);
            PG8_WAIT_L(8); PG8_BAR; PG8_WAIT_L(0); PG8_MMA(0, 0, At, B0); PG8_BAR; PG8_SCHED;
            PG8_LDB(B1, 0, 1); PG8_STAGE(PG8_SB(0, 0), b2, voffB);
            PG8_BAR; PG8_WAIT_L(0); PG8_MMA(0, 1, At, B1); PG8_BAR;
            PG8_LDA(At, 0, 1); PG8_STAGE(PG8_SA(0, 0), a2, voffA);
            PG8_BAR; PG8_WAIT_L(0); PG8_MMA(1, 0, At, B0); PG8_BAR; PG8_SCHED;
            PG8_STAGE(PG8_SB(0, 1), b2 + hstep, voffB);
            PG8_WAIT_V(6); PG8_BAR; PG8_MMA(1, 1, At, B1); PG8_BAR;
            PG8_LDB(B0, 1, 0); PG8_SCHED; PG8_LDA(At, 1, 0); PG8_STAGE(PG8_SA(0, 1), a2 + hstep, voffA);
            PG8_WAIT_L(8); PG8_BAR; PG8_WAIT_L(0); PG8_MMA(0, 0, At, B0); PG8_BAR; PG8_SCHED;
            PG8_LDB(B1, 1, 1); PG8_STAGE(PG8_SB(1, 0), b3, voffB);
            PG8_BAR; PG8_WAIT_L(0); PG8_MMA(0, 1, At, B1); PG8_BAR;
            PG8_LDA(At, 1, 1); PG8_STAGE(PG8_SA(1, 0), a3, voffA);
            PG8_BAR; PG8_WAIT_L(0); PG8_MMA(1, 0, At, B0); PG8_BAR; PG8_SCHED;
            PG8_STAGE(PG8_SB(1, 1), b3 + hstep, voffB);
            PG8_WAIT_V(6); PG8_BAR; PG8_MMA(1, 1, At, B1); PG8_BAR;
            }
        }
        if constexpr (ALIGN_EPI) { if (wr == 0) PG8_BAR; }
        E(acc, cur, wr, wc, fr, fq);
        if (!has_next) break;
#pragma unroll
        for (int a = 0; a < 2; ++a)
#pragma unroll
            for (int b = 0; b < 2; ++b)
#pragma unroll
                for (int m = 0; m < 4; ++m)
#pragma unroll
                    for (int n = 0; n < 2; ++n) acc[a][b][m][n] = (f32x4){0.f, 0.f, 0.f, 0.f};
        cur = nxt; cA = nA; cB = nB; ++ui;
        if constexpr (ALIGN_EPI) { if (wr == 1) PG8_BAR; }
    }
    PG8_WAIT_V(0);
    if constexpr (!ALIGN_EPI) { if (wr == 0) PG8_BAR; }
    PG8_BAR;
#undef PG8_SA
#undef PG8_SB
#undef PG8_STAGE
#undef PG8_LDA
#undef PG8_LDB
#undef PG8_MMA
#undef PG8_WAIT_V
#undef PG8_WAIT_L
#undef PG8_BAR
#undef PG8_SCHED
}
}
using pg8::cvt_pk_bf16;
using pg8::Unit;

__device__ __forceinline__ float fast_sigmoid(float x) { return __builtin_amdgcn_rcpf(1.0f + __expf(-x)); }

__device__ __forceinline__ void ln_stats(const float* ST, int row, float& mu, float& rstd) {
    const f32x2 sq = *(const f32x2*)(ST + 2 * (size_t)row);
    mu = sq[0] * (1.0f / DM); const float var = sq[1] * (1.0f / DM) - mu * mu; rstd = __builtin_amdgcn_rsqf(var + LN_EPS);
}
__device__ __forceinline__ void ln_finish(const f32x2 sq, float& mu, float& rstd) { mu = sq[0] * (1.0f / DM); rstd = __builtin_amdgcn_rsqf(sq[1] * (1.0f / DM) - mu * mu + LN_EPS); }
#define EPI_ROW(i) (row0 + ((i) >> 2) * 128 + ((i) & 3) * 16)
template <bool LN> struct EpiSwiglu {
    static constexpr bool PERM = true;
    bf16_t* O; const float* ST; const float* S; const float* C;
    __device__ __forceinline__ void operator()(const f32x4 (&acc)[2][2][4][2], const Unit& u, int wr, int wc, int fr, int fq) const {
        const int row0 = u.pm * 256 + wr * 64 + fr, col0 = u.pn * 128 + wc * 32 + 8 * fq, gc0 = u.pn * 256 + wc * 32 + 8 * fq;
        f32x4 sg0, sg1, su0, su1, cg0, cg1, cu0, cu1;
        if (LN) { sg0 = *(const f32x4*)(S + gc0); sg1 = *(const f32x4*)(S + gc0 + 4); su0 = *(const f32x4*)(S + gc0 + 128); su1 = *(const f32x4*)(S + gc0 + 132);
                  cg0 = *(const f32x4*)(C + gc0); cg1 = *(const f32x4*)(C + gc0 + 4); cu0 = *(const f32x4*)(C + gc0 + 128); cu1 = *(const f32x4*)(C + gc0 + 132); }
#pragma unroll
        for (int ai = 0; ai < 2; ++ai)
#pragma unroll
            for (int m = 0; m < 4; ++m) {
                const int row = row0 + ai * 128 + m * 16;
                f32x4 g0 = acc[ai][0][m][0], g1 = acc[ai][0][m][1], u0 = acc[ai][1][m][0], u1 = acc[ai][1][m][1];
                if (LN) { float mu, rstd; ln_stats(ST, row, mu, rstd);
                    g0 = (g0 - sg0 * mu) * rstd + cg0; g1 = (g1 - sg1 * mu) * rstd + cg1; u0 = (u0 - su0 * mu) * rstd + cu0; u1 = (u1 - su1 * mu) * rstd + cu1; }
                float v[8];
#pragma unroll
                for (int j = 0; j < 4; ++j) { v[j] = g0[j] * fast_sigmoid(g0[j]) * u0[j]; v[4 + j] = g1[j] * fast_sigmoid(g1[j]) * u1[j]; }
                u32x4 w; w.x = cvt_pk_bf16(v[0], v[1]); w.y = cvt_pk_bf16(v[2], v[3]); w.z = cvt_pk_bf16(v[4], v[5]); w.w = cvt_pk_bf16(v[6], v[7]);
                *(u32x4*)(O + (size_t)row * FF + col0) = w;
            }
    }
};
template <bool LN, bool HALF> struct EpiResid {
    static constexpr bool PERM = true;
    const bf16_t* RB; bf16_t* TB; const float* stIn; const float* gIn; const float* bIn; float* stOut;
    static constexpr float sacc = HALF ? 0.5f : 1.0f;
    __device__ __forceinline__ void operator()(const f32x4 (&acc)[2][2][4][2], const Unit& u, int wr, int wc, int fr, int fq) const {
        const int row0 = u.pm * 256 + wr * 64 + fr, col0 = u.pn * 256 + wc * 32 + 8 * fq;
        f32x2 sqn = {0.f, 0.f};
        if (LN) sqn = *(const f32x2*)(stIn + 2 * (size_t)row0);
#pragma unroll
        for (int ai = 0; ai < 2; ++ai)
#pragma unroll
            for (int m = 0; m < 4; ++m) {
                const int row = row0 + ai * 128 + m * 16;
                const size_t off = (size_t)row * DM + col0;
                float mu = 0.f, rstd = 1.f;
                if (LN) { const f32x2 sqc = sqn; if (ai * 4 + m < 7) sqn = *(const f32x2*)(stIn + 2 * (size_t)EPI_ROW(ai * 4 + m + 1)); ln_finish(sqc, mu, rstd); }
                float ps = 0.f, pq = 0.f;
#pragma unroll
                for (int bj = 0; bj < 2; ++bj) {
                    const u32x4 rw = *(const u32x4*)(RB + off + bj * 128);
                    f32x4 r0, r1;
                    r0[0] = __uint_as_float(rw.x << 16); r0[1] = __uint_as_float(rw.x & 0xffff0000u); r0[2] = __uint_as_float(rw.y << 16); r0[3] = __uint_as_float(rw.y & 0xffff0000u);
                    r1[0] = __uint_as_float(rw.z << 16); r1[1] = __uint_as_float(rw.z & 0xffff0000u); r1[2] = __uint_as_float(rw.w << 16); r1[3] = __uint_as_float(rw.w & 0xffff0000u);
                    if (LN) { const f32x4 g0 = *(const f32x4*)(gIn + col0 + bj * 128), g1 = *(const f32x4*)(gIn + col0 + bj * 128 + 4), b0 = *(const f32x4*)(bIn + col0 + bj * 128), b1 = *(const f32x4*)(bIn + col0 + bj * 128 + 4);
                              r0 = (r0 - mu) * rstd * g0 + b0; r1 = (r1 - mu) * rstd * g1 + b1; }
                    const f32x4 t0 = r0 * ALPHA + acc[ai][bj][m][0] * sacc, t1 = r1 * ALPHA + acc[ai][bj][m][1] * sacc;
                    u32x4 w; w.x = cvt_pk_bf16(t0[0], t0[1]); w.y = cvt_pk_bf16(t0[2], t0[3]); w.z = cvt_pk_bf16(t1[0], t1[1]); w.w = cvt_pk_bf16(t1[2], t1[3]);
                    *(u32x4*)(TB + off + bj * 128) = w;
                    const float q0 = __uint_as_float(w.x << 16), q1 = __uint_as_float(w.x & 0xffff0000u), q2 = __uint_as_float(w.y << 16), q3 = __uint_as_float(w.y & 0xffff0000u),
                                q4 = __uint_as_float(w.z << 16), q5 = __uint_as_float(w.z & 0xffff0000u), q6 = __uint_as_float(w.w << 16), q7 = __uint_as_float(w.w & 0xffff0000u);
                    ps += ((q0 + q1) + (q2 + q3)) + ((q4 + q5) + (q6 + q7));
                    pq += ((q0 * q0 + q1 * q1) + (q2 * q2 + q3 * q3)) + ((q4 * q4 + q5 * q5) + (q6 * q6 + q7 * q7));
                }
                ps += __shfl_xor(ps, 16); ps += __shfl_xor(ps, 32); pq += __shfl_xor(pq, 16); pq += __shfl_xor(pq, 32);
                if (fq == 0) { atomicAdd(stOut + 2 * (size_t)row, ps); atomicAdd(stOut + 2 * (size_t)row + 1, pq); }
                if (m & 1) asm volatile("" ::: "memory");
            }
    }
};
struct EpiBf16 {
    static constexpr bool PERM = true;
    bf16_t* O; int ldc;
    __device__ __forceinline__ void operator()(const f32x4 (&acc)[2][2][4][2], const Unit& u, int wr, int wc, int fr, int fq) const {
        const int row0 = u.pm * 256 + wr * 64 + fr, col0 = u.pn * 256 + wc * 32 + 8 * fq;
#pragma unroll
        for (int ai = 0; ai < 2; ++ai)
#pragma unroll
            for (int m = 0; m < 4; ++m)
#pragma unroll
                for (int bj = 0; bj < 2; ++bj) {
                    const f32x4 v0 = acc[ai][bj][m][0], v1 = acc[ai][bj][m][1];
                    u32x4 w; w.x = cvt_pk_bf16(v0[0], v0[1]); w.y = cvt_pk_bf16(v0[2], v0[3]); w.z = cvt_pk_bf16(v1[0], v1[1]); w.w = cvt_pk_bf16(v1[2], v1[3]);
                    *(u32x4*)(O + (size_t)(row0 + ai * 128 + m * 16) * ldc + col0 + bj * 128) = w;
                }
    }
};
struct EpiWin {
    static constexpr bool PERM = true;
    bf16_t* Z; const float* rope; const float* ST; const float* S; const float* C;
    __device__ __forceinline__ void operator()(const f32x4 (&acc)[2][2][4][2], const Unit& u, int wr, int wc, int fr, int fq) const {
        const int tile = u.pn;
        const int row0 = u.pm * 256 + wr * 64 + fr;
        f32x4 s4[2][2], c4[2][2];
#pragma unroll
        for (int bj = 0; bj < 2; ++bj)
#pragma unroll
            for (int n = 0; n < 2; ++n) { const int gc = tile * 256 + bj * 128 + wc * 32 + 8 * fq + 4 * n; s4[bj][n] = *(const f32x4*)(S + gc); c4[bj][n] = *(const f32x4*)(C + gc); }
        f32x2 sqn = *(const f32x2*)(ST + 2 * (size_t)row0);
#pragma unroll
        for (int ai = 0; ai < 2; ++ai)
#pragma unroll
            for (int m = 0; m < 4; ++m) {
                const int row = row0 + ai * 128 + m * 16;
                const int pos = (row >= MP) ? 4096 + ((row - MP) & 63) : (row & 8191);
                float mu, rstd; { const f32x2 sqc = sqn; if (ai * 4 + m < 7) sqn = *(const f32x2*)(ST + 2 * (size_t)EPI_ROW(ai * 4 + m + 1)); ln_finish(sqc, mu, rstd); }
#pragma unroll
                for (int bj = 0; bj < 2; ++bj) {
                    f32x4 v0 = (acc[ai][bj][m][0] - s4[bj][0] * mu) * rstd + c4[bj][0], v1 = (acc[ai][bj][m][1] - s4[bj][1] * mu) * rstd + c4[bj][1];
                    const int cin = bj * 128 + wc * 32 + 8 * fq;
                    if (tile < 2 || (tile == 2 && bj == 0)) {
                        f32x4 p0, p1;
#pragma unroll
                        for (int j = 0; j < 4; ++j) { p0[j] = __shfl_xor(v0[j], 16); p1[j] = __shfl_xor(v1[j], 16); }
                        if ((wc & 1) == 0 && fq < 2) {
                            const f32x4* rp = (const f32x4*)(rope + (size_t)pos * 16);
                            const f32x4 c0 = rp[0], c1 = rp[1], s0 = rp[2], s1 = rp[3];
                            const float sg = (fq == 0) ? -1.f : 1.f;
                            v0 = v0 * c0 + p0 * s0 * sg; v1 = v1 * c1 + p1 * s1 * sg;
                        }
                    }
                    u32x4 w; w.x = cvt_pk_bf16(v0[0], v0[1]); w.y = cvt_pk_bf16(v0[2], v0[3]); w.z = cvt_pk_bf16(v1[0], v1[1]); w.w = cvt_pk_bf16(v1[2], v1[3]);
                    *(u32x4*)(Z + (size_t)row * NIN + tile * 256 + cin) = w;
                }
                asm volatile("" ::: "memory");
            }
    }
};
struct EpiFinal {
    static constexpr bool PERM = true;
    float* Y; const bf16_t* TB; const bf16_t* PE; const float* ST; const float* S; const float* C; const float* g3; const float* b3;
    __device__ __forceinline__ void operator()(const f32x4 (&acc)[2][2][4][2], const Unit& u, int wr, int wc, int fr, int fq) const {
        const int row0 = u.pm * 256 + wr * 64 + fr, col0 = u.pn * 256 + wc * 32 + 8 * fq;
        f32x2 sqn = *(const f32x2*)(ST + 2 * (size_t)row0);
#pragma unroll
        for (int ai = 0; ai < 2; ++ai)
#pragma unroll
            for (int m = 0; m < 4; ++m) {
                const int row = row0 + ai * 128 + m * 16;
                const size_t off = (size_t)row * DM + col0;
                float mu, rstd; { const f32x2 sqc = sqn; if (ai * 4 + m < 7) sqn = *(const f32x2*)(ST + 2 * (size_t)EPI_ROW(ai * 4 + m + 1)); ln_finish(sqc, mu, rstd); }
#pragma unroll
                for (int bj = 0; bj < 2; ++bj) {
                    const u32x4 tw = *(const u32x4*)(TB + off + bj * 128), pw = *(const u32x4*)(PE + off + bj * 128);
                    const unsigned tws[4] = {tw.x, tw.y, tw.z, tw.w}, pws[4] = {pw.x, pw.y, pw.z, pw.w};
#pragma unroll
                    for (int n = 0; n < 2; ++n) {
                        const int cc = col0 + bj * 128 + 4 * n;
                        const f32x4 g4 = *(const f32x4*)(g3 + cc), b4 = *(const f32x4*)(b3 + cc), s4 = *(const f32x4*)(S + cc), c4 = *(const f32x4*)(C + cc);
                        f32x4 t, pe;
                        t[0] = __uint_as_float(tws[2 * n] << 16); t[1] = __uint_as_float(tws[2 * n] & 0xffff0000u); t[2] = __uint_as_float(tws[2 * n + 1] << 16); t[3] = __uint_as_float(tws[2 * n + 1] & 0xffff0000u);
                        pe[0] = __uint_as_float(pws[2 * n] << 16); pe[1] = __uint_as_float(pws[2 * n] & 0xffff0000u); pe[2] = __uint_as_float(pws[2 * n + 1] << 16); pe[3] = __uint_as_float(pws[2 * n + 1] & 0xffff0000u);
                        const f32x4 h = (t - mu) * rstd * g4 + b4;
                        const f32x4 a = (acc[ai][bj][m][n] - s4 * mu) * rstd + c4;
                        f32x4 y;
#pragma unroll
                        for (int j = 0; j < 4; ++j) y[j] = h[j] + fast_sigmoid(a[j]) * pe[j];
                        *(f32x4*)(Y + off + bj * 128 + 4 * n) = y;
                    }
                }
                if (m & 1) asm volatile("" ::: "memory");
            }
    }
};

template <class Inner, int S, int NN, int IDX> struct EpiSplit {
    static constexpr bool PERM = Inner::PERM;
    Inner inner; unsigned char* ws;
    __device__ __forceinline__ void operator()(f32x4 (&acc)[2][2][4][2], const Unit& u, int wr, int wc, int fr, int fq) const {
        const int tile = (u.pm - 256) * NN + u.pn, tid = threadIdx.x;
        unsigned char* wb = ws; asm volatile("" : "+s"(wb));
        float* buf = (float*)(wb + WS_ACCB) + (size_t)(IDX * 8 + tile) * 65536 + tid;
        unsigned* tickets = (unsigned*)(wb + WS_STATS + WS_TICK_OFF) + IDX * 8;
        volatile LAS unsigned* flag = (volatile LAS unsigned*)(unsigned)(131072 + 336);
        float* p = buf;
#pragma unroll
        for (int ai = 0; ai < 2; ++ai)
#pragma unroll
            for (int bj = 0; bj < 2; ++bj)
#pragma unroll
                for (int m = 0; m < 4; ++m)
#pragma unroll
                    for (int n = 0; n < 2; ++n)
#pragma unroll
                        for (int j = 0; j < 4; ++j) { atomicAdd(p, acc[ai][bj][m][n][j]); p += 512; asm volatile("" : "+v"(p)); }
        asm volatile("s_waitcnt vmcnt(0)" ::: "memory");
        __syncthreads();
        if (tid == 0) { __threadfence(); const unsigned old = atomicAdd(tickets + tile, 1u); *flag = (old == (unsigned)(S - 1)) ? 1u : 0u; }
        __syncthreads();
        if (*flag != 0u) {
            __builtin_amdgcn_fence(__ATOMIC_ACQUIRE, "agent");
            p = buf;
#pragma unroll
            for (int ai = 0; ai < 2; ++ai)
#pragma unroll
                for (int bj = 0; bj < 2; ++bj)
#pragma unroll
                    for (int m = 0; m < 4; ++m)
#pragma unroll
                        for (int n = 0; n < 2; ++n)
#pragma unroll
                            for (int j = 0; j < 4; ++j) { acc[ai][bj][m][n][j] = __hip_atomic_load(p, __ATOMIC_RELAXED, __HIP_MEMORY_SCOPE_AGENT); p += 512; asm volatile("" : "+v"(p)); }
            inner(acc, u, wr, wc, fr, fq);
        }
    }
};

struct Args { const float* in[32]; float* out; unsigned char* ws; };

__device__ __forceinline__ float wave_sum(float v) {
#pragma unroll
    for (int o = 1; o < 64; o <<= 1) v += __shfl_xor(v, o);
    return v;
}
__device__ __forceinline__ float bf2f(unsigned short h) { return __uint_as_float(((unsigned)h) << 16); }

__device__ __forceinline__ void cvt_f32_bf16(const float* src, bf16_t* dst, size_t ngroups, size_t gt, size_t gs) {
    size_t i = gt;
    for (; i + 7 * gs < ngroups; i += 8 * gs) {
        f32x4 v[8][2];
#pragma unroll
        for (int k = 0; k < 8; ++k) { const float* sp = src + (i + k * gs) * 8; v[k][0] = *(const f32x4*)sp; v[k][1] = *(const f32x4*)(sp + 4); }
#pragma unroll
        for (int k = 0; k < 8; ++k) { u32x4 w; w.x = cvt_pk_bf16(v[k][0][0], v[k][0][1]); w.y = cvt_pk_bf16(v[k][0][2], v[k][0][3]); w.z = cvt_pk_bf16(v[k][1][0], v[k][1][1]); w.w = cvt_pk_bf16(v[k][1][2], v[k][1][3]);
            *(u32x4*)(dst + (i + k * gs) * 8) = w; }
    }
    for (; i < ngroups; i += gs) {
        const float* sp = src + i * 8; const f32x4 v0 = *(const f32x4*)sp, v1 = *(const f32x4*)(sp + 4);
        u32x4 w; w.x = cvt_pk_bf16(v0[0], v0[1]); w.y = cvt_pk_bf16(v0[2], v0[3]); w.z = cvt_pk_bf16(v1[0], v1[1]); w.w = cvt_pk_bf16(v1[2], v1[3]);
        *(u32x4*)(dst + i * 8) = w;
    }
}

__device__ __forceinline__ void transpose_item(const float* W, int K, int N, bf16_t* WT, int k0, int n0, int drow0, LAS float* scr, int lane,
                                               const float* gk, const float* bk, float* S, float* C) {
    float cpart = 0.f;
#pragma unroll
    for (int i = 0; i < 32; ++i) { const int kk = 2 * i + (lane >> 5); float w = W[(size_t)(k0 + kk) * N + n0 + (lane & 31)];
        if (gk) { cpart += bk[k0 + kk] * w; w *= gk[k0 + kk]; }
        scr[kk * 33 + (lane & 31)] = w; }
    if (gk) { cpart += __shfl_xor(cpart, 32); if (lane < 32) atomicAdd(C + drow0 + lane, cpart); }
    asm volatile("s_waitcnt lgkmcnt(0)" ::: "memory");
    const int c = lane & 7;
#pragma unroll
    for (int j = 0; j < 4; ++j) { const int n = (lane >> 3) + 8 * j; const LAS float* sp = scr + (8 * c) * 33 + n;
        u32x4 o; o.x = cvt_pk_bf16(sp[0 * 33], sp[1 * 33]); o.y = cvt_pk_bf16(sp[2 * 33], sp[3 * 33]); o.z = cvt_pk_bf16(sp[4 * 33], sp[5 * 33]); o.w = cvt_pk_bf16(sp[6 * 33], sp[7 * 33]);
        *(u32x4*)(WT + (size_t)(drow0 + n) * K + k0 + 8 * c) = o;
        if (gk) {
            float sp8 = (__uint_as_float(o.x << 16) + __uint_as_float(o.x & 0xffff0000u)) + (__uint_as_float(o.y << 16) + __uint_as_float(o.y & 0xffff0000u))
                      + (__uint_as_float(o.z << 16) + __uint_as_float(o.z & 0xffff0000u)) + (__uint_as_float(o.w << 16) + __uint_as_float(o.w & 0xffff0000u));
            sp8 += __shfl_xor(sp8, 1); sp8 += __shfl_xor(sp8, 2); sp8 += __shfl_xor(sp8, 4);
            if (c == 0) atomicAdd(S + drow0 + n, sp8);
        } }
    asm volatile("s_waitcnt lgkmcnt(0)" ::: "memory");
}
__device__ __forceinline__ void transpose_matrix_item(const float* W, int K, int N, bf16_t* WT, int mode, int item, LAS float* scr, int lane,
                                                      const float* gk = nullptr, const float* bk = nullptr, float* S = nullptr, float* C = nullptr) {
    const int nblk = N / 32, kb = item / nblk, nb = item % nblk, n0 = 32 * nb;
    const int drow0 = (mode == 0) ? n0 : ((n0 >> 7) * 256 + (n0 & 127) + (mode == 2 ? 128 : 0));
    transpose_item(W, K, N, WT, 64 * kb, n0, drow0, scr, lane, gk, bk, S, C);
}

__device__ __forceinline__ void ln_row(float* trow, const float* g, const float* b, bf16_t* hrow, int lane) {
    f32x4* xr = (f32x4*)trow + lane;
    f32x4 v[4]; float s = 0.f;
#pragma unroll
    for (int j = 0; j < 4; ++j) { v[j] = xr[64 * j]; s += (v[j][0] + v[j][1]) + (v[j][2] + v[j][3]); }
    const float mean = wave_sum(s) * (1.f / DM); float s2 = 0.f;
#pragma unroll
    for (int j = 0; j < 4; ++j) { v[j] = v[j] - mean; s2 += (v[j][0] * v[j][0] + v[j][1] * v[j][1]) + (v[j][2] * v[j][2] + v[j][3] * v[j][3]); }
    const float rstd = 1.f / sqrtf(wave_sum(s2) * (1.f / DM) + LN_EPS);
    u32x2* o8 = (u32x2*)hrow + lane;
#pragma unroll
    for (int j = 0; j < 4; ++j) {
        const f32x4 gg = ((const f32x4*)g)[lane + 64 * j], bb = ((const f32x4*)b)[lane + 64 * j];
        const f32x4 y = v[j] * rstd * gg + bb;
        xr[64 * j] = y;
        u32x2 w; w.x = cvt_pk_bf16(y[0], y[1]); w.y = cvt_pk_bf16(y[2], y[3]); o8[64 * j] = w;
    }
}

constexpr int KP = 72  , VP = 196  ;
constexpr int ATT_K_OFF = 0, ATT_V_OFF = 192 * KP * 2;
__device__ __forceinline__ void attn_unit(LAS unsigned char* lds, const bf16_t* Z, bf16_t* MIX, const float* cache_k, const float* cache_v, const float* sinks, int item) {
    const int tid = threadIdx.x, lane = tid & 63, wave = __builtin_amdgcn_readfirstlane(tid >> 6), l16 = lane & 15, fq = lane >> 4;
    const bool samp = item >= 2048;
    int b, c, kvh;
    if (samp) { const int s = item - 2048; kvh = s & 1; b = s >> 1; c = 2; } else { kvh = item & 1; c = (item >> 1) & 127; b = item >> 8; }
    const int qtok0 = samp ? (MP + b * 64) : (b * 8192 + c * 64);
    const int k_lo = (!samp && c < 2) ? (2 - c) * 64 : 0;
    LAS bf16_t* KL = (LAS bf16_t*)(lds + ATT_K_OFF);
    LAS bf16_t* VL = (LAS bf16_t*)(lds + ATT_V_OFF);
    __syncthreads();
#pragma unroll
    for (int i = 0; i < 3; ++i) {
        const int p = tid + 512 * i, row = p >> 3, seg = p & 7;
        u32x4 kv = {0u, 0u, 0u, 0u}, vv = {0u, 0u, 0u, 0u};
        if (samp && row < 128) {
            const float* ks = cache_k + ((size_t)(b * 128 + row) * 128 + kvh * 64 + seg * 8);
            const float* vs = cache_v + ((size_t)(b * 128 + row) * 128 + kvh * 64 + seg * 8);
            const f32x4 k0 = *(const f32x4*)ks, k1 = *(const f32x4*)(ks + 4), v0 = *(const f32x4*)vs, v1 = *(const f32x4*)(vs + 4);
            kv.x = cvt_pk_bf16(k0[0], k0[1]); kv.y = cvt_pk_bf16(k0[2], k0[3]); kv.z = cvt_pk_bf16(k1[0], k1[1]); kv.w = cvt_pk_bf16(k1[2], k1[3]);
            vv.x = cvt_pk_bf16(v0[0], v0[1]); vv.y = cvt_pk_bf16(v0[2], v0[3]); vv.z = cvt_pk_bf16(v1[0], v1[1]); vv.w = cvt_pk_bf16(v1[2], v1[3]);
        } else if (row >= k_lo) {
            const int tok = samp ? (MP + b * 64 + (row - 128)) : (b * 8192 + (c - 2) * 64 + row);
            const bf16_t* zr = Z + (size_t)tok * NIN + kvh * 64 + seg * 8;
            kv = *(const u32x4*)(zr + 512); vv = *(const u32x4*)(zr + 640);
        }
        *(LAS u32x4*)(KL + row * KP + seg * 8) = kv;
        LAS bf16_t* vd = VL + (seg * 8) * VP + row;
        vd[0 * VP] = (bf16_t)(vv.x & 0xffff); vd[1 * VP] = (bf16_t)(vv.x >> 16); vd[2 * VP] = (bf16_t)(vv.y & 0xffff); vd[3 * VP] = (bf16_t)(vv.y >> 16);
        vd[4 * VP] = (bf16_t)(vv.z & 0xffff); vd[5 * VP] = (bf16_t)(vv.z >> 16); vd[6 * VP] = (bf16_t)(vv.w & 0xffff); vd[7 * VP] = (bf16_t)(vv.w >> 16);
    }
    __syncthreads();
    const int g = wave >> 1, qh = wave & 1, h = kvh * 4 + g;
    const float sink = sinks[h];
    bf16x8 Qf[2][2];
#pragma unroll
    for (int qt = 0; qt < 2; ++qt)
#pragma unroll
        for (int ks = 0; ks < 2; ++ks) Qf[qt][ks] = *(const bf16x8*)(Z + (size_t)(qtok0 + 32 * qh + 16 * qt + l16) * NIN + h * 64 + 32 * ks + 8 * fq);
    f32x4 S[12][2];
#pragma unroll
    for (int kt = 0; kt < 12; ++kt) {
        S[kt][0] = (f32x4){0.f, 0.f, 0.f, 0.f}; S[kt][1] = (f32x4){0.f, 0.f, 0.f, 0.f};
#pragma unroll
        for (int ks = 0; ks < 2; ++ks) {
            const bf16x8 Kf = *(const LAS bf16x8*)(KL + (16 * kt + l16) * KP + 32 * ks + 8 * fq);
            S[kt][0] = __builtin_amdgcn_mfma_f32_16x16x32_bf16(Kf, Qf[0][ks], S[kt][0], 0, 0, 0);
            S[kt][1] = __builtin_amdgcn_mfma_f32_16x16x32_bf16(Kf, Qf[1][ks], S[kt][1], 0, 0, 0);
        }
    }
    float inv[2];
#pragma unroll
    for (int qt = 0; qt < 2; ++qt) {
        float mx = sink;
#pragma unroll
        for (int kt = 0; kt < 12; ++kt) {
            const bool ok = (16 * kt >= k_lo);
#pragma unroll
            for (int r = 0; r < 4; ++r) { const float s = ok ? S[kt][qt][r] * 0.125f : -1e30f; S[kt][qt][r] = s; mx = fmaxf(mx, s); }
        }
        mx = fmaxf(mx, __shfl_xor(mx, 16)); mx = fmaxf(mx, __shfl_xor(mx, 32));
        float sum = 0.f;
#pragma unroll
        for (int kt = 0; kt < 12; ++kt)
#pragma unroll
            for (int r = 0; r < 4; ++r) { const float p = __expf(S[kt][qt][r] - mx); S[kt][qt][r] = p; sum += p; }
        sum += __shfl_xor(sum, 16); sum += __shfl_xor(sum, 32);
        sum += __expf(sink - mx);
        inv[qt] = 1.0f / sum;
    }
    f32x4 O[4][2];
#pragma unroll
    for (int dt = 0; dt < 4; ++dt) { O[dt][0] = (f32x4){0.f, 0.f, 0.f, 0.f}; O[dt][1] = (f32x4){0.f, 0.f, 0.f, 0.f}; }
#pragma unroll
    for (int kp = 0; kp < 6; ++kp) {
        bf16x8 Pf[2];
#pragma unroll
        for (int qt = 0; qt < 2; ++qt) {
            u32x4 w; const f32x4 a = S[2 * kp][qt], bq = S[2 * kp + 1][qt];
            w.x = cvt_pk_bf16(a[0], a[1]); w.y = cvt_pk_bf16(a[2], a[3]); w.z = cvt_pk_bf16(bq[0], bq[1]); w.w = cvt_pk_bf16(bq[2], bq[3]);
            Pf[qt] = __builtin_bit_cast(bf16x8, w);
        }
#pragma unroll
        for (int dt = 0; dt < 4; ++dt) {
            const LAS bf16_t* vp = VL + (16 * dt + l16) * VP + 32 * kp + 4 * fq;
            const u32x2 lo = *(const LAS u32x2*)vp, hi = *(const LAS u32x2*)(vp + 16);
            u32x4 w; w.x = lo.x; w.y = lo.y; w.z = hi.x; w.w = hi.y;
            const bf16x8 Vf = __builtin_bit_cast(bf16x8, w);
            O[dt][0] = __builtin_amdgcn_mfma_f32_16x16x32_bf16(Vf, Pf[0], O[dt][0], 0, 0, 0);
            O[dt][1] = __builtin_amdgcn_mfma_f32_16x16x32_bf16(Vf, Pf[1], O[dt][1], 0, 0, 0);
        }
    }
#pragma unroll
    for (int qt = 0; qt < 2; ++qt)
#pragma unroll
        for (int dt = 0; dt < 4; ++dt) {
            const f32x4 o = O[dt][qt] * inv[qt];
            u32x2 w; w.x = cvt_pk_bf16(o[0], o[1]); w.y = cvt_pk_bf16(o[2], o[3]);
            *(u32x2*)(MIX + (size_t)(qtok0 + 32 * qh + 16 * qt + l16) * DM + h * 64 + 16 * dt + 4 * fq) = w;
        }
}

template <int CTRL> __device__ __forceinline__ float dpp_shr(float idv, float v) {
    return __int_as_float(__builtin_amdgcn_update_dpp(__float_as_int(idv), __float_as_int(v), CTRL, 0xf, 0xf, false));
}
constexpr int XSP = 72;
constexpr int LRU_WAVE_BYTES = 10240;
struct LruP { const bf16_t* Z; bf16_t* MIX; const bf16_t* WaT; const bf16_t* WxT; const float *conv_w, *conv_b, *ba, *bx, *lam, *state_conv, *state_h; float *CP, *CH, *out; };
template <bool PASSC>
__device__ __forceinline__ void lru_unit(LAS unsigned char* lds, const LruP& P, int unit, int blk = -1) {
    const int tid = threadIdx.x, lane = tid & 63, wave = __builtin_amdgcn_readfirstlane(tid >> 6), l16 = lane & 15, fq = lane >> 4;
    const bool samp = unit >= 1024;
    const int b = samp ? unit - 1024 : unit >> 7, c = samp ? 0 : ((unit & 127) + 32 * ((unit >> 8) & 3)) & 127;
    const int tok0 = samp ? MP + b * 64 : b * 8192 + c * 64;
    const int nb = (blk >= 0) ? blk : wave;
    const int ch0 = nb * 64;
    LAS bf16_t* XS = (LAS bf16_t*)(lds + wave * LRU_WAVE_BYTES);
    LAS float* HS = (LAS float*)(lds + wave * LRU_WAVE_BYTES + 9728);
#pragma unroll
    for (int i = 0; i < 9; ++i) {
        const int p = lane + 64 * i;
        if (p < 536) {
            const int r = p >> 3, seg = p & 7, tr = r - 3;
            u32x4 v = {0u, 0u, 0u, 0u};
            if (tr >= 0 || (!samp && c > 0)) v = *(const u32x4*)(P.Z + (size_t)(tok0 + tr) * NIN + 768 + ch0 + seg * 8);
            else if (samp) {
                const float* s = P.state_conv + ((size_t)(b * 3 + r) * 512 + ch0 + seg * 8);
                const f32x4 a0 = *(const f32x4*)s, a1 = *(const f32x4*)(s + 4);
                v.x = cvt_pk_bf16(a0[0], a0[1]); v.y = cvt_pk_bf16(a0[2], a0[3]); v.z = cvt_pk_bf16(a1[0], a1[1]); v.w = cvt_pk_bf16(a1[2], a1[3]);
            }
            *(LAS u32x4*)(XS + r * XSP + seg * 8) = v;
        }
    }
    if (PASSC) {
        float hst = 0.f;
        if (samp) hst = P.state_h[b * 512 + ch0 + lane];
        else {
            const float* cp = P.CP + (size_t)(b * 128) * 512 + ch0 + lane; const float* chp = P.CH + (size_t)(b * 128) * 512 + ch0 + lane;
#pragma unroll 16
            for (int cc = 0; cc < c; ++cc) hst = cp[(size_t)cc * 512] * hst + chp[(size_t)cc * 512];
        }
        HS[lane] = hst;
    }
    bf16x8 Xf[4][2];
#pragma unroll
    for (int ks = 0; ks < 2; ++ks) {
        const int chl = 32 * ks + 8 * fq;
        float cw[4][8], cb[8];
#pragma unroll
        for (int j = 0; j < 4; ++j) { const f32x4 a0 = *(const f32x4*)(P.conv_w + j * 512 + ch0 + chl), a1 = *(const f32x4*)(P.conv_w + j * 512 + ch0 + chl + 4);
#pragma unroll
            for (int e = 0; e < 4; ++e) { cw[j][e] = a0[e]; cw[j][4 + e] = a1[e]; } }
        { const f32x4 a0 = *(const f32x4*)(P.conv_b + ch0 + chl), a1 = *(const f32x4*)(P.conv_b + ch0 + chl + 4);
#pragma unroll
            for (int e = 0; e < 4; ++e) { cb[e] = a0[e]; cb[4 + e] = a1[e]; } }
#pragma unroll
        for (int tt = 0; tt < 4; ++tt) {
            float xc[8];
#pragma unroll
            for (int e = 0; e < 8; ++e) xc[e] = cb[e];
#pragma unroll
            for (int j = 0; j < 4; ++j) {
                const u32x4 xv = *(const LAS u32x4*)(XS + (16 * tt + l16 + j) * XSP + chl);
                xc[0] += cw[j][0] * __uint_as_float(xv.x << 16); xc[1] += cw[j][1] * __uint_as_float(xv.x & 0xffff0000u);
                xc[2] += cw[j][2] * __uint_as_float(xv.y << 16); xc[3] += cw[j][3] * __uint_as_float(xv.y & 0xffff0000u);
                xc[4] += cw[j][4] * __uint_as_float(xv.z << 16); xc[5] += cw[j][5] * __uint_as_float(xv.z & 0xffff0000u);
                xc[6] += cw[j][6] * __uint_as_float(xv.w << 16); xc[7] += cw[j][7] * __uint_as_float(xv.w & 0xffff0000u);
            }
            u32x4 w; w.x = cvt_pk_bf16(xc[0], xc[1]); w.y = cvt_pk_bf16(xc[2], xc[3]); w.z = cvt_pk_bf16(xc[4], xc[5]); w.w = cvt_pk_bf16(xc[6], xc[7]);
            Xf[tt][ks] = __builtin_bit_cast(bf16x8, w);
        }
    }
#pragma unroll 1
    for (int ct = 0; ct < 4; ++ct) {
        const int chq = ch0 + 16 * ct + 4 * fq;
        f32x4 ga[4], gx[4], gi[4];
#pragma unroll
        for (int tt = 0; tt < 4; ++tt) { ga[tt] = (f32x4){0.f, 0.f, 0.f, 0.f}; gx[tt] = (f32x4){0.f, 0.f, 0.f, 0.f}; gi[tt] = (f32x4){0.f, 0.f, 0.f, 0.f}; }
#pragma unroll
        for (int ks = 0; ks < 2; ++ks) {
            const size_t wo = (size_t)nb * 4096 + (size_t)(16 * ct + l16) * 64 + 32 * ks + 8 * fq;
            const bf16x8 wa = *(const bf16x8*)(P.WaT + wo), wx = *(const bf16x8*)(P.WxT + wo);
            const int tgt = 16 * ct + l16 - 32 * ks - 8 * fq;
            const unsigned one = (tgt & 1) ? 0x3f800000u : 0x00003f80u;
            u32x4 iw; iw.x = (tgt >> 1) == 0 ? one : 0u; iw.y = (tgt >> 1) == 1 ? one : 0u; iw.z = (tgt >> 1) == 2 ? one : 0u; iw.w = (tgt >> 1) == 3 ? one : 0u;
            const bf16x8 wi = __builtin_bit_cast(bf16x8, iw);
#pragma unroll
            for (int tt = 0; tt < 4; ++tt) {
                ga[tt] = __builtin_amdgcn_mfma_f32_16x16x32_bf16(wa, Xf[tt][ks], ga[tt], 0, 0, 0);
                gx[tt] = __builtin_amdgcn_mfma_f32_16x16x32_bf16(wx, Xf[tt][ks], gx[tt], 0, 0, 0);
                gi[tt] = __builtin_amdgcn_mfma_f32_16x16x32_bf16(wi, Xf[tt][ks], gi[tt], 0, 0, 0);
            }
        }
        const f32x4 vba = *(const f32x4*)(P.ba + chq), vbx = *(const f32x4*)(P.bx + chq), vlam = *(const f32x4*)(P.lam + chq);
        const f32x4 c8 = vlam;
        f32x4 hprev = {0.f, 0.f, 0.f, 0.f}, ptot = {1.f, 1.f, 1.f, 1.f};
        if (PASSC) hprev = *(const LAS f32x4*)(HS + 16 * ct + 4 * fq);
#pragma unroll
        for (int tt = 0; tt < 4; ++tt) {
            const f32x4 xcv = gi[tt];
            f32x4 hv, pv;
#pragma unroll
            for (int r = 0; r < 4; ++r) {
                const float rr = fast_sigmoid(ga[tt][r] + vba[r]), ii = fast_sigmoid(gx[tt][r] + vbx[r]);
                const float la = c8[r] * rr;
                const float Pv = __expf(la);
                const float x2 = 2.0f * la;
                const float ser = -x2 * __builtin_fmaf(x2, 0.5f, 1.0f);
                const float om = (x2 > -0.0078125f) ? ser : __builtin_fmaf(-Pv, Pv, 1.0f);
                float Hv = __builtin_amdgcn_sqrtf(om) * (ii * xcv[r]);
                const float cin = (tt == 0) ? hprev[r] : dpp_shr<0x121>(0.f, hprev[r]);
                Hv = (l16 == 0) ? __builtin_fmaf(Pv, cin, Hv) : Hv;
                hv[r] = Hv; pv[r] = Pv;
            }
#define LRU_SCAN_STEP(N) \
            "v_fmac_f32_dpp %0, %0, %4 row_shr:" #N " row_mask:0xf bank_mask:0xf\n\t" "v_fmac_f32_dpp %1, %1, %5 row_shr:" #N " row_mask:0xf bank_mask:0xf\n\t" \
            "v_fmac_f32_dpp %2, %2, %6 row_shr:" #N " row_mask:0xf bank_mask:0xf\n\t" "v_fmac_f32_dpp %3, %3, %7 row_shr:" #N " row_mask:0xf bank_mask:0xf\n\t" \
            "v_mul_f32_dpp %4, %4, %4 row_shr:" #N " row_mask:0xf bank_mask:0xf\n\t" "v_mul_f32_dpp %5, %5, %5 row_shr:" #N " row_mask:0xf bank_mask:0xf\n\t" \
            "v_mul_f32_dpp %6, %6, %6 row_shr:" #N " row_mask:0xf bank_mask:0xf\n\t" "v_mul_f32_dpp %7, %7, %7 row_shr:" #N " row_mask:0xf bank_mask:0xf\n\t"
            {
                float h0 = hv[0], h1 = hv[1], h2 = hv[2], h3 = hv[3], p0 = pv[0], p1 = pv[1], p2 = pv[2], p3 = pv[3];
                asm("s_nop 1\n\t" LRU_SCAN_STEP(1) LRU_SCAN_STEP(2) LRU_SCAN_STEP(4) LRU_SCAN_STEP(8)
                    : "+v"(h0), "+v"(h1), "+v"(h2), "+v"(h3), "+v"(p0), "+v"(p1), "+v"(p2), "+v"(p3));
                hv[0] = h0; hv[1] = h1; hv[2] = h2; hv[3] = h3; pv[0] = p0; pv[1] = p1; pv[2] = p2; pv[3] = p3;
            }
#undef LRU_SCAN_STEP
            hprev = hv;
            if (!PASSC) ptot = ptot * pv;
            if (PASSC) {
                const size_t tok = (size_t)(tok0 + 16 * tt + l16);
                const u32x2 gw = *(const u32x2*)(P.Z + tok * NIN + 1280 + chq);
                f32x4 gb; gb[0] = __uint_as_float(gw.x << 16); gb[1] = __uint_as_float(gw.x & 0xffff0000u); gb[2] = __uint_as_float(gw.y << 16); gb[3] = __uint_as_float(gw.y & 0xffff0000u);
                f32x4 y;
#pragma unroll
                for (int r = 0; r < 4; ++r) { const float x = gb[r]; const float yy = 0.7978845608028654f * (x + 0.044715f * x * x * x); y[r] = hv[r] * x * fast_sigmoid(2.0f * yy); }
                u32x2 w; w.x = cvt_pk_bf16(y[0], y[1]); w.y = cvt_pk_bf16(y[2], y[3]);
                *(u32x2*)(P.MIX + tok * DM + 512 + chq) = w;
            }
        }
        if (l16 == 15) {
            if (PASSC) {
                if (samp) *(f32x4*)(P.out + O_NHS + b * 512 + chq) = hprev;
                else if (c == 127) *(f32x4*)(P.out + O_NHP + b * 512 + chq) = hprev;
            } else {
                *(f32x4*)(P.CP + (size_t)(b * 128 + c) * 512 + chq) = ptot;
                *(f32x4*)(P.CH + (size_t)(b * 128 + c) * 512 + chq) = hprev;
            }
        }
    }
}

#define XB_TMO      128
#define XB_XCNT(j)  (256  + 64 * (j))
#define XB_XSUB(j)  (1280 + 64 * (j))
#define XB_XGEN(j)  (2304 + 64 * (j))
#define XB_TOP      3328
#define XB_TOPGEN   3392
#define XCD_BAR_WORDS 3456
#define XB_SPIN_CAP (1u << 18)
__device__ __forceinline__ unsigned xb_ld(unsigned* p)              { return __hip_atomic_load(p, __ATOMIC_RELAXED, __HIP_MEMORY_SCOPE_AGENT); }
__device__ __forceinline__ unsigned xb_add(unsigned* p, unsigned v) { return __hip_atomic_fetch_add(p, v, __ATOMIC_RELAXED, __HIP_MEMORY_SCOPE_AGENT); }
__device__ __forceinline__ unsigned xb_xcc_id() { return (unsigned)__builtin_amdgcn_s_getreg((3 << 11) | 20) & 0xFu; }
#define XB_SPIN(cond, bar) do { unsigned _sp = 0; while (cond) { __builtin_amdgcn_s_sleep(1); \
    if ((++_sp & 255u) == 0u) { if (xb_ld(&(bar)[XB_TMO])) break; if (_sp > XB_SPIN_CAP) { atomicAdd(&(bar)[XB_TMO], 1u); break; } } } } while (0)
struct XcdBarrier { unsigned* bar; unsigned x; volatile LAS unsigned* st; };
__device__ __forceinline__ XcdBarrier xcd_barrier_post(unsigned* bar, volatile LAS unsigned* st) {
    XcdBarrier b; b.bar = bar; b.x = xb_xcc_id(); b.st = st;
    if (threadIdx.x == 0) (void)xb_add(&bar[XB_XCNT(b.x)], 1u);
    return b;
}
__device__ __forceinline__ void xcd_barrier_complete(unsigned* bar, unsigned x, unsigned& nloc, unsigned& nx) {
    const unsigned G = gridDim.x * gridDim.y * gridDim.z;
    unsigned sum, cnt, mine, sp = 0u;
    for (;;) {
        sum = 0u; cnt = 0u; mine = 0u;
#pragma unroll
        for (unsigned j = 0; j < 16; ++j) { const unsigned c = xb_ld(&bar[XB_XCNT(j)]); sum += c; cnt += (c > 0u) ? 1u : 0u; mine = (j == x) ? c : mine; }
        if (sum == G) break;
        __builtin_amdgcn_s_sleep(1);
        if ((++sp & 255u) == 0u) { if (xb_ld(&bar[XB_TMO])) break; if (sp > XB_SPIN_CAP) { atomicAdd(&bar[XB_TMO], 1u); break; } }
    }
    nloc = mine > 0u ? mine : 1u; nx = cnt > 0u ? cnt : 1u;
}
__device__ __forceinline__ void xcd_barrier(const XcdBarrier& b) {
    asm volatile("s_waitcnt vmcnt(0)" ::: "memory");
    __syncthreads();
    if (threadIdx.x == 0) {
        unsigned* bar = b.bar;
        __builtin_amdgcn_s_waitcnt(0);
        unsigned nloc = b.st[0], nx = b.st[1];
        if (nloc == 0u) { xcd_barrier_complete(bar, b.x, nloc, nx); b.st[0] = nloc; b.st[1] = nx; }
        const unsigned old = xb_add(&bar[XB_XSUB(b.x)], 1u);
        const unsigned gen = old / nloc;
        if (old + 1u == (gen + 1u) * nloc) {
            __builtin_amdgcn_fence(__ATOMIC_RELEASE, "agent");
            asm volatile("s_waitcnt vmcnt(0)" ::: "memory");
            const unsigned og = xb_add(&bar[XB_TOP], 1u);
            const unsigned tg = og / nx;
            if (og + 1u == (tg + 1u) * nx) xb_add(&bar[XB_TOPGEN], 1u);
            else XB_SPIN(xb_ld(&bar[XB_TOPGEN]) == tg, bar);
            __builtin_amdgcn_fence(__ATOMIC_ACQUIRE, "agent");
            xb_add(&bar[XB_XGEN(b.x)], 1u);
            asm volatile("s_waitcnt vmcnt(0)" ::: "memory");
        } else {
            XB_SPIN(xb_ld(&bar[XB_XGEN(b.x)]) == gen, bar);
            __builtin_amdgcn_fence(__ATOMIC_ACQUIRE, "agent");
            asm volatile("s_waitcnt vmcnt(0)" ::: "memory");
        }
    }
    __syncthreads();
}

#ifndef PHMASK
#define PHMASK 0xffff
#endif
constexpr int LDS_BYTES = 147456;
__global__ void __launch_bounds__(512, 2) fwd(Args a) {
    extern __shared__ __attribute__((aligned(16))) unsigned char lds_raw[];
    LAS unsigned char* lds = (LAS unsigned char*)lds_raw;
    cg::grid_group grid = cg::this_grid();
    const int tid = threadIdx.x, lane = tid & 63, wave = __builtin_amdgcn_readfirstlane(tid >> 6);
    const int G = gridDim.x, bx = blockIdx.x;
    const int gw = bx * 8 + wave, NGW = G * 8;
    unsigned char* ws = a.ws;
    float* out = a.out;
    bf16_t* W1GU = (bf16_t*)(ws + WS_W1GU); bf16_t* W1D = (bf16_t*)(ws + WS_W1D); bf16_t* WIN = (bf16_t*)(ws + WS_WIN); bf16_t* WOUT = (bf16_t*)(ws + WS_WOUT);
    bf16_t* W2GU = (bf16_t*)(ws + WS_W2GU); bf16_t* W2D = (bf16_t*)(ws + WS_W2D); bf16_t* WPG = (bf16_t*)(ws + WS_WPG); bf16_t* WPLE = (bf16_t*)(ws + WS_WPLE);
    bf16_t* WAT = (bf16_t*)(ws + WS_LRUW); bf16_t* WXT = WAT + 8 * 4096;
    float* C8T = (float*)(ws + WS_LRUW + 256 * 1024);
    float* ROPE = (float*)(ws + WS_ROPE); float* CP = (float*)(ws + WS_CP); float* CH = (float*)(ws + WS_CH);
    bf16_t* XB = (bf16_t*)(ws + WS_XB); bf16_t* MIX = XB; bf16_t* ACT = (bf16_t*)(ws + WS_ACT); bf16_t* PE = MIX;
    bf16_t* H1 = (bf16_t*)(ws + WS_H1); bf16_t* H3 = H1; bf16_t* Z = (bf16_t*)(ws + WS_Z); bf16_t* H2 = Z; bf16_t* PB = (bf16_t*)(ws + WS_PB);
    float* ST1 = (float*)(ws + WS_STATS); float* ST2 = ST1 + 2 * MT; float* ST3 = ST2 + 2 * MT;
    float* SC_IN_S = ST3 + 2 * MT; float* SC_IN_C = SC_IN_S + NIN; float* SC_GU_S = SC_IN_C + NIN; float* SC_GU_C = SC_GU_S + 2 * FF; float* SC_PG_S = SC_GU_C + 2 * FF; float* SC_PG_C = SC_PG_S + DM;
    bf16_t* TB1 = H1; bf16_t* TB2 = H2; bf16_t* TB3 = H3;
    float* T1 = out;
    volatile LAS unsigned* xst = (volatile LAS unsigned*)(lds + 131072 + 320);
    if (tid < 2) xst[tid] = 0u;
    __syncthreads();
    const XcdBarrier xbar = xcd_barrier_post((unsigned*)(ws + WS_STATS + WS_BAR_OFF), xst);
#define GRID_BAR() xcd_barrier(xbar)
    float* ACCB = (float*)(ws + WS_ACCB);
    {
        LAS float* scr = (LAS float*)(lds + wave * 16384);
        constexpr int I_GU = 16 * 88, I_D = 44 * 32, I_IN = 16 * 56, I_SQ = 16 * 32, I_PLE = 4 * 32, I_LRU = 2;
        constexpr int NITEMS = 4 * I_GU + 2 * I_D + I_IN + 2 * I_SQ + I_PLE + 16 * I_LRU;
        for (int it = gw; it < NITEMS; it += NGW) {
            int r = it;
            if (r < I_GU) { transpose_matrix_item(a.in[8], DM, FF, W1GU, 1, r, scr, lane); continue; } r -= I_GU;
            if (r < I_GU) { transpose_matrix_item(a.in[9], DM, FF, W1GU, 2, r, scr, lane); continue; } r -= I_GU;
            if (r < I_GU) { transpose_matrix_item(a.in[25], DM, FF, W2GU, 1, r, scr, lane, a.in[23], a.in[24], SC_GU_S, SC_GU_C); continue; } r -= I_GU;
            if (r < I_GU) { transpose_matrix_item(a.in[26], DM, FF, W2GU, 2, r, scr, lane, a.in[23], a.in[24], SC_GU_S, SC_GU_C); continue; } r -= I_GU;
            if (r < I_D) { transpose_matrix_item(a.in[10], FF, DM, W1D, 0, r, scr, lane); continue; } r -= I_D;
            if (r < I_D) { transpose_matrix_item(a.in[27], FF, DM, W2D, 0, r, scr, lane); continue; } r -= I_D;
            if (r < I_IN) { transpose_matrix_item(a.in[13], DM, NIN, WIN, 0, r, scr, lane, a.in[11], a.in[12], SC_IN_S, SC_IN_C); continue; } r -= I_IN;
            if (r < I_SQ) { transpose_matrix_item(a.in[22], DM, DM, WOUT, 0, r, scr, lane); continue; } r -= I_SQ;
            if (r < I_SQ) { transpose_matrix_item(a.in[31], DM, DM, WPG, 0, r, scr, lane, a.in[28], a.in[29], SC_PG_S, SC_PG_C); continue; } r -= I_SQ;
            if (r < I_PLE) { transpose_matrix_item(a.in[30], PLE, DM, WPLE, 0, r, scr, lane); continue; } r -= I_PLE;
            { const int blk = (r >> 1) & 7, which = r >> 4, sub = r & 1;
              transpose_matrix_item(a.in[which ? 19 : 17] + blk * 4096, 64, 64, (which ? WXT : WAT) + blk * 4096, 0, sub, scr, lane); }
        }
        const size_t gt = (size_t)bx * 512 + tid, gs = (size_t)G * 512;
        for (size_t i = gt; i < 512; i += gs) C8T[i] = -8.0f * log1pf(expf(-a.in[21][i]));
        for (size_t i = gt; i < (size_t)4 * 8 * 65536 / 4; i += gs) ((f32x4*)ACCB)[i] = (f32x4){0.f, 0.f, 0.f, 0.f};
        for (size_t i = gt; i < 8192 * 8; i += gs) {
            const int pos = (int)(i >> 3), j = (int)(i & 7);
            const float inv = powf(500000.0f, -(float)j * 0.125f);
            const float ang = (float)pos * inv;
            ROPE[pos * 16 + j] = cosf(ang); ROPE[pos * 16 + 8 + j] = sinf(ang);
        }
        cvt_f32_bf16(a.in[0], XB, (size_t)MP * DM / 8, gt, gs);
        cvt_f32_bf16(a.in[1], XB + (size_t)MP * DM, (size_t)MS * DM / 8, gt, gs);
        cvt_f32_bf16(a.in[2], PB, (size_t)MP * PLE / 8, gt, gs);
        cvt_f32_bf16(a.in[3], PB + (size_t)MP * PLE, (size_t)MS * PLE / 8, gt, gs);
        for (size_t i = gt; i < 8 * 64 * 128; i += gs) {
            const int b = (int)(i >> 13), rem = (int)(i & 8191);
            out[O_NKS + (size_t)b * 16384 + rem] = a.in[4][(size_t)b * 16384 + 8192 + rem];
            out[O_NVS + (size_t)b * 16384 + rem] = a.in[5][(size_t)b * 16384 + 8192 + rem];
        }
    }
    if (gridDim.y == 0x7fffu) grid.sync();
    GRID_BAR();
    { pg8::Gemm g{XB, W1GU, MT, 2 * FF, DM, DM}; pg8::StaticOrder S; S.init(MT, 2 * FF, G, bx); EpiSwiglu<false> E{ACT, nullptr, nullptr, nullptr};
      pg8::gemm_phase<EpiSwiglu<false>, pg8::StaticOrder, true, true>(lds, g, S, E); }
    GRID_BAR();
    { pg8::Gemm g{ACT, W1D, MT, DM, FF, FF}; pg8::StaticOrder S; S.init(MP, DM, G, bx); EpiResid<false, true> E{XB, TB1, nullptr, nullptr, nullptr, ST1};
      pg8::Gemm gs{ACT, W1D, MT, DM, FF, FF / 11}; pg8::SplitOrder SS; SS.init(DM, 11, G, bx); EpiSplit<EpiResid<false, true>, 11, 4, 0> ES{{XB, TB1, nullptr, nullptr, nullptr, ST1}, ws};
      pg8::gemm_phase<EpiSplit<EpiResid<false, true>, 11, 4, 0>, pg8::SplitOrder, true, true>(lds, gs, SS, ES);
      pg8::gemm_phase<EpiResid<false, true>, pg8::StaticOrder, true, true>(lds, g, S, E); }
    GRID_BAR();
    { pg8::Gemm g{TB1, WIN, MT, NIN, DM, DM}; pg8::StaticOrder S; S.init(MT, NIN, G, bx); EpiWin E{Z, ROPE, ST1, SC_IN_S, SC_IN_C};
      pg8::gemm_phase<EpiWin, pg8::StaticOrder, true, true>(lds, g, S, E); }
    GRID_BAR();
    LruP LP{Z, MIX, WAT, WXT, a.in[15], a.in[16], a.in[18], a.in[20], C8T, a.in[6], a.in[7], CP, CH, out};
#ifdef PROBE_REP56
    for (int rep56 = 0; rep56 < PROBE_REP56; ++rep56) {
#endif
    {
        const size_t gt = (size_t)bx * 512 + tid, gs = (size_t)G * 512;
        for (size_t i = gt; i < 2 * 8 * 128 * 256; i += gs) {
            const int col = (int)(i & 255), j = (int)((i >> 8) & 127), b = (int)((i >> 15) & 7), set = (int)(i >> 18);
            const int row = set ? (j >= 64 ? MP + b * 64 + (j - 64) : -1) : (b * 8192 + 8064 + j);
            if (row >= 0) {
                const float v = bf2f(Z[(size_t)row * NIN + 512 + col]);
                const size_t o = (col < 128) ? (set ? O_NKS : O_NKP) : (set ? O_NVS : O_NVP);
                out[o + (size_t)(b * 128 + j) * 128 + (col & 127)] = v;
            }
        }
        for (size_t i = gt; i < 2 * 8 * 3 * 512; i += gs) {
            const int ch = (int)(i & 511), r = (int)(i >> 9), j = r % 3, b = (r / 3) & 7, set = r / 24;
            const int row = set ? (MP + b * 64 + 61 + j) : (b * 8192 + 8189 + j);
            out[(set ? O_NCS : O_NCP) + (size_t)(b * 3 + j) * 512 + ch] = bf2f(Z[(size_t)row * NIN + 768 + ch]);
        }
    }
#ifndef PROBE_ATT
#define PROBE_ATT 1
#endif
#ifndef PROBE_LRUA
#define PROBE_LRUA 1
#endif
#ifndef PROBE_P6
#define PROBE_P6 1
#endif
    for (int rp = 0; rp < PROBE_ATT; ++rp)
    for (int it = bx; it < 2064; it += G) attn_unit(lds, Z, MIX, a.in[4], a.in[5], a.in[14], it);
    __syncthreads();
    for (int rp = 0; rp < PROBE_LRUA; ++rp)
    for (int it = bx; it < 1024; it += G) lru_unit<false>(lds, LP, it);
    if (G >= 80) { const int k = bx - (G - 64); if (k >= 0 && wave == 0) lru_unit<true>(lds, LP, 1024 + (k >> 3), k & 7); }
    else for (int it = bx; it < 8; it += G) lru_unit<true>(lds, LP, 1024 + it);
    GRID_BAR();
    for (int rp = 0; rp < PROBE_P6; ++rp)
    for (int it = bx; it < 1024; it += G) lru_unit<true>(lds, LP, it);
    GRID_BAR();
#ifdef PROBE_REP56
    }
#endif
    { pg8::Gemm g{MIX, WOUT, MT, DM, DM, DM}; pg8::StaticOrder S; S.init(MP, DM, G, bx); EpiResid<true, false> E{TB1, TB2, ST1, a.in[11], a.in[12], ST2};
      pg8::Gemm gs{MIX, WOUT, MT, DM, DM, DM / 4}; pg8::SplitOrder SS; SS.init(DM, 4, G, bx); EpiSplit<EpiResid<true, false>, 4, 4, 1> ES{{TB1, TB2, ST1, a.in[11], a.in[12], ST2}, ws};
      pg8::gemm_phase<EpiSplit<EpiResid<true, false>, 4, 4, 1>, pg8::SplitOrder, true, true>(lds, gs, SS, ES);
      pg8::gemm_phase<EpiResid<true, false>, pg8::StaticOrder, true, true>(lds, g, S, E); }
    GRID_BAR();
    { pg8::Gemm g{TB2, W2GU, MT, 2 * FF, DM, DM}; pg8::StaticOrder S; S.init(MT, 2 * FF, G, bx); EpiSwiglu<true> E{ACT, ST2, SC_GU_S, SC_GU_C};
      pg8::gemm_phase<EpiSwiglu<true>, pg8::StaticOrder, true, true>(lds, g, S, E); }
    { pg8::Gemm g{PB, WPLE, MT, DM, PLE, PLE}; pg8::StaticOrder S; S.init(MT, DM, G, bx); EpiBf16 E{PE, DM};
      pg8::gemm_phase<EpiBf16, pg8::StaticOrder, true, true>(lds, g, S, E); }
    GRID_BAR();
    { pg8::Gemm g{ACT, W2D, MT, DM, FF, FF}; pg8::StaticOrder S; S.init(MP, DM, G, bx); EpiResid<true, true> E{TB2, TB3, ST2, a.in[23], a.in[24], ST3};
      pg8::Gemm gs{ACT, W2D, MT, DM, FF, FF / 11}; pg8::SplitOrder SS; SS.init(DM, 11, G, bx); EpiSplit<EpiResid<true, true>, 11, 4, 2> ES{{TB2, TB3, ST2, a.in[23], a.in[24], ST3}, ws};
      pg8::gemm_phase<EpiSplit<EpiResid<true, true>, 11, 4, 2>, pg8::SplitOrder, true, true>(lds, gs, SS, ES);
      pg8::gemm_phase<EpiResid<true, true>, pg8::StaticOrder, true, true>(lds, g, S, E); }
    GRID_BAR();
    { pg8::Gemm g{TB3, WPG, MT, DM, DM, DM}; pg8::StaticOrder S; S.init(MP, DM, G, bx); EpiFinal E{T1, TB3, PE, ST3, SC_PG_S, SC_PG_C, a.in[28], a.in[29]};
      pg8::Gemm gs{TB3, WPG, MT, DM, DM, DM / 4}; pg8::SplitOrder SS; SS.init(DM, 4, G, bx); EpiSplit<EpiFinal, 4, 4, 3> ES{{T1, TB3, PE, ST3, SC_PG_S, SC_PG_C, a.in[28], a.in[29]}, ws};
      pg8::gemm_phase<EpiSplit<EpiFinal, 4, 4, 3>, pg8::SplitOrder, true, true>(lds, gs, SS, ES);
      pg8::gemm_phase<EpiFinal, pg8::StaticOrder, true, true>(lds, g, S, E); }
}

extern "C" void kernel_launch(void* const* d_in, const int* in_sizes, int n_in, void* d_out, int out_size, void* d_ws, size_t ws_size, hipStream_t stream) {
    static int grid = 0;
    if (grid == 0) {
        if (n_in != 32 || ws_size < WS_END) { fprintf(stderr, "kernel_launch: unexpected n_in %d / ws %zu\n", n_in, ws_size); grid = -1; return; }
        int dev = 0, cus = 0, per_cu = 0;
        (void)hipGetDevice(&dev);
        (void)hipDeviceGetAttribute(&cus, hipDeviceAttributeMultiprocessorCount, dev);
        (void)hipFuncSetAttribute((const void*)fwd, hipFuncAttributeMaxDynamicSharedMemorySize, LDS_BYTES);
        (void)hipOccupancyMaxActiveBlocksPerMultiprocessor(&per_cu, (const void*)fwd, 512, LDS_BYTES);
        if (per_cu < 1) per_cu = 1;
        grid = cus * per_cu;
    }
    if (grid < 0) return;
    if (hipMemsetAsync((char*)d_ws + WS_STATS, 0, STATS_ZERO_BYTES, stream) != hipSuccess) { fprintf(stderr, "kernel_launch: memset failed\n"); return; }
    Args a{};
    for (int i = 0; i < 32; ++i) a.in[i] = (const float*)d_in[i];
    a.out = (float*)d_out; a.ws = (unsigned char*)d_ws;
    void* args[] = {&a};
    hipError_t e = hipLaunchCooperativeKernel((const void*)fwd, dim3(grid), dim3(512), args, LDS_BYTES, stream);
    if (e != hipSuccess) fprintf(stderr, "cooperative launch failed: %s (grid %d)\n", hipGetErrorString(e), grid);
}
```
